# Optimizing an MI355X kernel written in HIP

```python
import math
import jax, jax.numpy as jnp
from jax import lax
import numpy as np

D_MODEL = 1024
BATCH = 32
SEQ = 2048
DEPTH = 1

CHUNK = 64
CONV_DIM = D_MODEL // 2
CONV_WIDTH = 3
ATTN_HEADS = 8
HEAD_DIM = 64
ATTN_DIM = ATTN_HEADS * HEAD_DIM
Q_BLOCK = 128
IN_SPLITS = (CONV_DIM, CONV_DIM, CONV_DIM, ATTN_DIM, ATTN_DIM, ATTN_DIM, ATTN_HEADS, D_MODEL, D_MODEL)
IN_COLS = sum(IN_SPLITS)
N_EXPERTS = 32
TOP_K = 4
D_FF = D_MODEL
SWIGLU_ALPHA = 1.702
SWIGLU_LIMIT = 7.0
ROUTE_BLOCK = 256
RMS_EPS = 1e-5

kernel_name = "hybrid_gated_conv_fox_moe_block"


def rmsnorm(x, g):
    xf = x.astype(jnp.float32)
    y = xf * lax.rsqrt(jnp.mean(xf * xf, axis=-1, keepdims=True) + RMS_EPS)
    return y.astype(x.dtype) * g


def split_cols(u):
    idx = np.cumsum(IN_SPLITS)[:-1].tolist()
    return jnp.split(u, idx, axis=-1)


def short_gated_conv(b_gate, c_gate, xc, conv_w):
    u = c_gate * xc
    S = u.shape[1]
    up = jnp.pad(u, ((0, 0), (CONV_WIDTH - 1, 0), (0, 0)))
    conv = sum(conv_w[j] * up[:, j:j + S] for j in range(CONV_WIDTH))
    return b_gate * conv


def forgetting_attention(q, k, v, logf):
    Bsz, S, H, Dh = q.shape
    nb = S // Q_BLOCK
    scale = 1.0 / math.sqrt(Dh)
    c = jnp.cumsum(logf, axis=1).transpose(0, 2, 1)
    kh = k.transpose(0, 2, 1, 3)
    vh = v.transpose(0, 2, 1, 3)
    qb = q.reshape(Bsz, nb, Q_BLOCK, H, Dh).transpose(1, 0, 3, 2, 4)
    cb = c.reshape(Bsz, H, nb, Q_BLOCK).transpose(2, 0, 1, 3)
    key_pos = jnp.arange(S)

    def block(args):
        qi, ci, i = args
        q_pos = i * Q_BLOCK + jnp.arange(Q_BLOCK)
        s = jnp.einsum('bhqd,bhkd->bhqk', qi, kh).astype(jnp.float32) * scale
        s = s + (ci[..., :, None] - c[:, :, None, :])
        s = jnp.where(key_pos[None, :] <= q_pos[:, None], s, -jnp.inf)
        p = jax.nn.softmax(s, axis=-1).astype(vh.dtype)
        return jnp.einsum('bhqk,bhkd->bhqd', p, vh)

    o = lax.map(block, (qb, cb, jnp.arange(nb)))
    return o.transpose(1, 0, 3, 2, 4).reshape(Bsz, S, H * Dh)


def moe_ffn(h, w_router, b_router, w_gate_up, b_gate_up, w_down, b_down):
    N, D = h.shape
    logits = (h @ w_router + b_router).astype(jnp.float32)
    top_val, top_idx = lax.top_k(logits, TOP_K)
    gates = jax.nn.softmax(top_val, axis=-1)
    M = N * TOP_K
    flat_e = top_idx.reshape(-1)
    flat_tok = (jnp.arange(M) // TOP_K).astype(jnp.int32)
    flat_w = gates.reshape(-1)
    order = jnp.argsort(flat_e, stable=True)
    sorted_e = flat_e[order]
    counts = jnp.bincount(flat_e, length=N_EXPERTS)
    padded = ((counts + ROUTE_BLOCK - 1) // ROUTE_BLOCK) * ROUTE_BLOCK
    start = jnp.cumsum(counts) - counts
    pend = jnp.cumsum(padded)
    pstart = pend - padded
    dest = pstart[sorted_e] + (jnp.arange(M) - start[sorted_e])
    n_blocks = -(-M // ROUTE_BLOCK) + N_EXPERTS
    P = n_blocks * ROUTE_BLOCK
    slot_tok = jnp.full((P,), N, jnp.int32).at[dest].set(flat_tok[order])
    slot_w = jnp.zeros((P,), h.dtype).at[dest].set(flat_w[order].astype(h.dtype))
    block_e = jnp.minimum(jnp.searchsorted(pend, jnp.arange(n_blocks) * ROUTE_BLOCK, side='right'), N_EXPERTS - 1)
    h_pad = jnp.concatenate([h, jnp.zeros((1, D), h.dtype)], axis=0)
    xs = h_pad[slot_tok].reshape(n_blocks, ROUTE_BLOCK, D)

    def expert_block(args):
        xb, e = args
        gu = xb @ w_gate_up[e] + b_gate_up[e]
        x_glu, x_lin = jnp.split(gu, 2, axis=-1)
        x_glu = jnp.minimum(x_glu, SWIGLU_LIMIT)
        x_lin = jnp.clip(x_lin, -SWIGLU_LIMIT, SWIGLU_LIMIT)
        act = (x_glu * jax.nn.sigmoid(SWIGLU_ALPHA * x_glu)) * (x_lin + 1.0)
        return act @ w_down[e] + b_down[e]

    ys = lax.map(expert_block, (xs, block_e)).reshape(P, D)
    out = jnp.zeros((N + 1, D), h.dtype).at[slot_tok].add(ys * slot_w[:, None])
    return out[:N]


def setup_inputs(seed: int = 0) -> dict:
    key = jax.random.key(seed)
    ks = jax.random.split(key, 16)
    f32 = jnp.float32
    nrm = lambda k, shp, s: jax.random.normal(k, shp, f32) * s
    return {
        "x": nrm(ks[0], (BATCH, SEQ, D_MODEL), 1.0),
        "g_mix": 1.0 + nrm(ks[1], (D_MODEL,), 0.02),
        "w_in": nrm(ks[2], (D_MODEL, IN_COLS), D_MODEL ** -0.5),
        "conv_w": nrm(ks[3], (CONV_WIDTH, CONV_DIM), CONV_WIDTH ** -0.5),
        "b_f": 3.0 + nrm(ks[4], (ATTN_HEADS,), 0.5),
        "w_conv_o": nrm(ks[5], (CONV_DIM, D_MODEL), CONV_DIM ** -0.5),
        "w_attn_o": nrm(ks[6], (ATTN_DIM, D_MODEL), ATTN_DIM ** -0.5),
        "w_out": nrm(ks[7], (D_MODEL, D_MODEL), D_MODEL ** -0.5),
        "g_ffn": 1.0 + nrm(ks[8], (D_MODEL,), 0.02),
        "w_router": nrm(ks[9], (D_MODEL, N_EXPERTS), D_MODEL ** -0.5),
        "b_router": nrm(ks[10], (N_EXPERTS,), 0.01),
        "w_gate_up": nrm(ks[11], (N_EXPERTS, D_MODEL, 2 * D_FF), D_MODEL ** -0.5),
        "b_gate_up": nrm(ks[12], (N_EXPERTS, 2 * D_FF), 0.01),
        "w_down": nrm(ks[13], (N_EXPERTS, D_FF, D_MODEL), D_FF ** -0.5),
        "b_down": nrm(ks[14], (N_EXPERTS, D_MODEL), 0.01),
        "g_final": 1.0 + nrm(ks[15], (D_MODEL,), 0.02),
    }


def reference(x, g_mix, w_in, conv_w, b_f, w_conv_o, w_attn_o, w_out, g_ffn, w_router, b_router, w_gate_up, b_gate_up, w_down, b_down, g_final):
    Bsz, S, D = x.shape
    for _ in range(DEPTH):
        h = rmsnorm(x, g_mix)
        u = h @ w_in
        cb, cc, cx, q, k, v, fl, gc, ga = split_cols(u)
        y_conv = short_gated_conv(cb, cc, cx, conv_w) @ w_conv_o
        logf = jax.nn.log_sigmoid((fl + b_f).astype(jnp.float32))
        hs = (Bsz, S, ATTN_HEADS, HEAD_DIM)
        o = forgetting_attention(q.reshape(hs), k.reshape(hs), v.reshape(hs), logf)
        y_attn = o @ w_attn_o
        mixed = jax.nn.sigmoid(gc) * y_conv + jax.nn.sigmoid(ga) * y_attn
        x = x + mixed @ w_out
        h2 = rmsnorm(x, g_ffn).reshape(Bsz * S, D)
        x = x + moe_ffn(h2, w_router, b_router, w_gate_up, b_gate_up, w_down, b_down).reshape(Bsz, S, D)
    return rmsnorm(x, g_final)
```

```cpp
#include <hip/hip_runtime.h>
#include <hip/hip_bf16.h>
#include <cstdio>
#include <cstdint>
#include <cmath>

#ifndef PROBE_REPEAT_PHASE
#define PROBE_REPEAT_PHASE (-1)
#endif

constexpr int NTOK = 65536, DMODEL = 1024, SEQLEN = 2048, NBATCH = 32, NHEADS = 8;
constexpr int NEXP = 32, LISTCAP = NTOK;
constexpr int INCOLS = 5128;
constexpr float RMS_EPS = 1e-5f;

namespace pg8 {
#define PG8_LAS __attribute__((address_space(3)))
typedef unsigned short bf16_t;
typedef short bf16x8 __attribute__((ext_vector_type(8)));
typedef float f32x4 __attribute__((ext_vector_type(4)));
typedef float f32x2 __attribute__((ext_vector_type(2)));
typedef unsigned u32x4 __attribute__((ext_vector_type(4)));
typedef int i32x4 __attribute__((ext_vector_type(4)));
typedef int i32x8 __attribute__((ext_vector_type(8)));
constexpr int BM = 256, BK = 64, HALF = 128, HTB = HALF * BK * 2  , STAGE_BYTES = 8 * HTB, NXCD = 8, WGM = 8;

__host__ __device__ __forceinline__ int lds_byte(int r, int c) { const int st = (r >> 4) * 2 + (c >> 5), rr = r & 15, cc = c & 31, ob = rr * 64 + cc * 2; return st * 1024 + (ob ^ (((ob >> 9) & 1) << 5)); }
__host__ __device__ __forceinline__ void stage_rc(int b, int& R, int& C) { const int st = b / 1024, sb = b % 1024, swz = sb ^ (((sb >> 9) & 1) << 5); R = (st >> 1) * 16 + swz / 64; C = (st & 1) * 32 + (swz % 64) / 2; }
__host__ __device__ __forceinline__ int perm32(int rho) { const int n = rho >> 4, i = rho & 15; return 8 * (i >> 2) + 4 * n + (i & 3); }

struct Unit { unsigned A, B, rows; int pm, pn, e, nvalid, lrows; };

struct GridOrder {
    int nM, nN, nwg, G, c;
    __device__ __forceinline__ void init(int nM_, int nN_, int G_, int c_) { nM = nM_; nN = nN_; nwg = nM * nN; G = G_; c = c_; }
    __device__ __forceinline__ bool map(int i, int& pm, int& pn) const {
        const long L = (long)i * G + c; if (L >= nwg) return false;
        int wgid = (int)L; { const int q = nwg / NXCD, r = nwg % NXCD, xcd = wgid % NXCD, off = wgid / NXCD; wgid = (xcd < r ? xcd * (q + 1) : r * (q + 1) + (xcd - r) * q) + off; }
        const int nig = WGM * nN, gid = wgid / nig, fm = gid * WGM, gsz = (nM - fm) < WGM ? (nM - fm) : WGM;
        pm = fm + ((wgid % nig) % gsz); pn = (wgid % nig) / gsz; return true;
    }
};

__device__ __forceinline__ unsigned cvt_pk_bf16(float lo, float hi) { unsigned r; asm volatile("v_cvt_pk_bf16_f32 %0, %1, %2" : "=v"(r) : "v"(lo), "v"(hi)); return r; }
__device__ __forceinline__ float bf_lo(unsigned w) { return __uint_as_float(w << 16); }
__device__ __forceinline__ float bf_hi(unsigned w) { return __uint_as_float(w & 0xffff0000u); }

template <class Epi, class Sched, bool GATHER, bool ALIGN_EPI, bool FP8 = false>
__device__ __forceinline__ void gemm_phase(PG8_LAS unsigned char* lds, const char* base, const int lda, const int ldb, const int nt, const Sched& S, const Epi& E, const int sc0 = 0x7f7f7f7f, PG8_LAS unsigned char* gaux = nullptr) {
    const int tid = threadIdx.x, wid = __builtin_amdgcn_readfirstlane(tid >> 6), lane = tid & 63, wr = wid >> 2, wc = wid & 3, fr = lane & 15, fq = lane >> 4;
    unsigned voffA[2][2], voffB1[2];
#pragma unroll
    for (int i = 0; i < 2; ++i) { int R, C; stage_rc(tid * 16 + i * 8192, R, C); const int Rb = Epi::PERM ? ((R & ~31) + perm32(R & 31)) : R;
        voffB1[i] = (unsigned)(Rb * ldb + C) * 2u;
#pragma unroll
        for (int h = 0; h < 2; ++h) { voffA[h][i] = (unsigned)((R + (GATHER ? HALF * h : 0)) * lda + C) * 2u; } }
    const unsigned hstepA = GATHER ? 0u : (unsigned)(HALF * lda * 2), hstepB = (unsigned)(HALF * ldb * 2);
    const unsigned kstep = (unsigned)(BK * 2);
    const unsigned ldsw = (unsigned)wid * 1024u;
    const int aoff = lds_byte(wr * 64 + fr, fq * 8), boff = lds_byte(wc * 32 + fr, fq * 8);
#define PG8_SA(b, h) (((b) * 2 + (h)) * HTB)
#define PG8_SB(b, h) ((4 + (b) * 2 + (h)) * HTB)
#define PG8_STAGE(bufoff, gbase, voff) do { _Pragma("unroll") for (int _i = 0; _i < 2; ++_i) \
        __builtin_amdgcn_global_load_lds((const unsigned*)(base + (unsigned)((gbase) + (voff)[_i])), (PG8_LAS unsigned*)(lds + (bufoff) + ldsw + _i * 8192), 16, 0, 0); } while (0)
#define PG8_LDA(dst, b, h) do { _Pragma("unroll") for (int m = 0; m < 4; ++m) _Pragma("unroll") for (int k = 0; k < 2; ++k) dst[m][k] = *(const PG8_LAS bf16x8*)(lds + PG8_SA(b, h) + aoff + m * 2048 + k * 1024); } while (0)
#define PG8_LDB(dst, b, h) do { _Pragma("unroll") for (int n = 0; n < 2; ++n) _Pragma("unroll") for (int k = 0; k < 2; ++k) dst[n][k] = *(const PG8_LAS bf16x8*)(lds + PG8_SB(b, h) + boff + n * 2048 + k * 1024); } while (0)
#define PG8_CAT(X) __builtin_shufflevector(__builtin_bit_cast(i32x4, (X)[0]), __builtin_bit_cast(i32x4, (X)[1]), 0, 1, 2, 3, 4, 5, 6, 7)
#define PG8_MMA(ai, bj, At, Bt) do { __builtin_amdgcn_s_setprio(1); _Pragma("unroll") for (int m = 0; m < 4; ++m) _Pragma("unroll") for (int n = 0; n < 2; ++n) { \
        if constexpr (FP8) acc[ai][bj][m][n] = __builtin_amdgcn_mfma_scale_f32_16x16x128_f8f6f4(PG8_CAT(Bt[n]), PG8_CAT(At[m]), acc[ai][bj][m][n], 0, 0, 0, sc0, 0, sc0); \
        else { _Pragma("unroll") for (int k = 0; k < 2; ++k) acc[ai][bj][m][n] = __builtin_amdgcn_mfma_f32_16x16x32_bf16(Bt[n][k], At[m][k], acc[ai][bj][m][n], 0, 0, 0); } } \
        __builtin_amdgcn_s_setprio(0); } while (0)
#define PG8_WAIT_V(n) asm volatile("s_waitcnt vmcnt(" #n ")" ::: "memory")
#define PG8_WAIT_L(n) asm volatile("s_waitcnt lgkmcnt(" #n ")" ::: "memory")
#define PG8_BAR __builtin_amdgcn_s_barrier()
#define PG8_SCHED __builtin_amdgcn_sched_barrier(0)
#define PG8_LDMA(u, par) __builtin_amdgcn_global_load_lds((const unsigned*)(base + (u).rows + (unsigned)tid * 4u), (PG8_LAS unsigned*)(gaux + (par) * 2048 + wid * 256), 4, 0, 0)
#define PG8_GOFF(u, par, vo) do { int _tid = threadIdx.x; asm volatile("" : "+v"(_tid)); _Pragma("unroll") for (int _i = 0; _i < 2; ++_i) { int _R, _C; stage_rc(_tid * 16 + _i * 8192, _R, _C); \
        _Pragma("unroll") for (int _h = 0; _h < 2; ++_h) { \
        const int _r = _R + HALF * _h; const int _t = ((const PG8_LAS int*)(gaux + (par) * 2048))[2 * (_r < (u).nvalid ? _r : 0)]; (vo)[_h][_i] = (unsigned)(_t * lda + _C) * 2u; } } } while (0)
    Unit cur, nxt; int ui = 0;
    if (!S.next(0, cur)) return;
    f32x4 acc[2][2][4][2];
#pragma unroll
    for (int a = 0; a < 2; ++a)
#pragma unroll
        for (int b = 0; b < 2; ++b)
#pragma unroll
            for (int m = 0; m < 4; ++m)
#pragma unroll
                for (int n = 0; n < 2; ++n) acc[a][b][m][n] = (f32x4){0.f, 0.f, 0.f, 0.f};
    bf16x8 At[4][2], B0[2][2], B1[2][2];
    if constexpr (GATHER) { if constexpr (Epi::BIAS_LDS) E.bias_dma(cur, 0, tid, wid); PG8_LDMA(cur, 0); PG8_WAIT_V(0); PG8_BAR; PG8_GOFF(cur, 0, voffA); cur.lrows = 0; }
    if constexpr (!GATHER && Epi::BIAS_LDS) { E.bias_dma(cur, 0, tid, wid); cur.lrows = 0; }
    unsigned cA = cur.A, cB = cur.B;
    PG8_STAGE(PG8_SB(0, 0), cB, voffB1); PG8_STAGE(PG8_SB(0, 1), cB + hstepB, voffB1); PG8_STAGE(PG8_SA(0, 0), cA, voffA[0]); PG8_STAGE(PG8_SA(0, 1), cA + hstepA, voffA[1]);
    if (wr == 1) PG8_BAR;
    PG8_WAIT_V(2); PG8_BAR;
    PG8_STAGE(PG8_SB(1, 0), cB + kstep, voffB1); PG8_STAGE(PG8_SA(1, 0), cA + kstep, voffA[0]); PG8_STAGE(PG8_SB(1, 1), cB + kstep + hstepB, voffB1);
    PG8_WAIT_V(6); PG8_BAR;
    for (;;) {
        const bool has_next = S.next(ui + 1, nxt);
        const unsigned nA = has_next ? nxt.A : cA, nB = has_next ? nxt.B : cB;
        const int gbn = (ui + 1) % 3;
        if constexpr (!GATHER && Epi::BIAS_LDS) { if (has_next) { E.bias_dma(nxt, gbn, tid, wid); nxt.lrows = gbn * 2048; } }
        if constexpr (GATHER) { if (has_next) { if constexpr (Epi::BIAS_LDS) E.bias_dma(nxt, gbn, tid, wid); PG8_LDMA(nxt, gbn); nxt.lrows = gbn * 2048; } }
        for (int t = 0; t < nt; t += 2) {
            const bool last = (t == nt - 2);
            const unsigned a1 = cA + (unsigned)(t + 1) * kstep;
            const unsigned a2 = last ? nA : cA + (unsigned)(t + 2) * kstep, b2 = last ? nB : cB + (unsigned)(t + 2) * kstep;
            const unsigned a3 = a2 + kstep, b3 = b2 + kstep;
            PG8_LDB(B0, 0, 0); PG8_LDB(B1, 0, 1); PG8_SCHED; PG8_LDA(At, 0, 0); PG8_STAGE(PG8_SA(1, 1), a1 + hstepA, voffA[1]);
            if constexpr (GATHER) { if (last && has_next) { PG8_GOFF(nxt, gbn, voffA); } }
            PG8_WAIT_V(8); PG8_WAIT_L(0); PG8_BAR; PG8_MMA(0, 0, At, B0); PG8_MMA(0, 1, At, B1); PG8_BAR; PG8_SCHED;
            PG8_LDA(At, 0, 1); PG8_STAGE(PG8_SB(0, 0), b2, voffB1); PG8_STAGE(PG8_SB(0, 1), b2 + hstepB, voffB1); PG8_STAGE(PG8_SA(0, 0), a2, voffA[0]);
            PG8_WAIT_V(8); PG8_WAIT_L(0); PG8_BAR; PG8_MMA(1, 0, At, B0); PG8_MMA(1, 1, At, B1); PG8_BAR; PG8_SCHED;
            PG8_LDB(B0, 1, 0); PG8_LDB(B1, 1, 1); PG8_SCHED; PG8_LDA(At, 1, 0); PG8_STAGE(PG8_SA(0, 1), a2 + hstepA, voffA[1]);
            PG8_WAIT_V(8); PG8_WAIT_L(0); PG8_BAR; PG8_MMA(0, 0, At, B0); PG8_MMA(0, 1, At, B1); PG8_BAR; PG8_SCHED;
            PG8_LDA(At, 1, 1); PG8_STAGE(PG8_SB(1, 0), b3, voffB1); PG8_STAGE(PG8_SB(1, 1), b3 + hstepB, voffB1); PG8_STAGE(PG8_SA(1, 0), a3, voffA[0]);
            PG8_WAIT_V(8); PG8_WAIT_L(0); PG8_BAR; PG8_MMA(1, 0, At, B0); PG8_MMA(1, 1, At, B1); PG8_BAR; PG8_SCHED;
        }
        if constexpr (ALIGN_EPI) { if (wr == 0) PG8_BAR; }
        const bool keep = E(acc, cur);
        if (!has_next) break;
        if (!keep) {
            const unsigned z_ = (unsigned)(uintptr_t)(lds + STAGE_BYTES);
#pragma unroll
            for (int a = 0; a < 2; ++a)
#pragma unroll
                for (int b = 0; b < 2; ++b)
#pragma unroll
                    for (int m = 0; m < 4; ++m)
#pragma unroll
                        for (int n = 0; n < 2; ++n) asm volatile("ds_read_b128 %0, %1" : "=v"(acc[a][b][m][n]) : "v"(z_) : "memory");
        }
        cur = nxt; cA = nA; cB = nB; ++ui;
        if constexpr (ALIGN_EPI) { if (wr == 1) PG8_BAR; }
    }
    PG8_WAIT_V(0);
    if constexpr (!ALIGN_EPI) { if (wr == 0) PG8_BAR; }
    PG8_BAR;
#undef PG8_SA
#undef PG8_SB
#undef PG8_STAGE
#undef PG8_LDA
#undef PG8_LDB
#undef PG8_MMA
#undef PG8_CAT
#undef PG8_WAIT_V
#undef PG8_WAIT_L
#undef PG8_BAR
#undef PG8_SCHED
#undef PG8_GOFF
#undef PG8_LDMA
}
}

namespace attn_body {
using bf16=__hip_bfloat16;
using bf16x8=__attribute__((ext_vector_type(8)))short;
using s16x4=__attribute__((ext_vector_type(4)))short;
using f32x16=__attribute__((ext_vector_type(16)))float;
using f32x4v=__attribute__((ext_vector_type(4)))float;
using u32x4=__attribute__((ext_vector_type(4)))unsigned;
constexpr int BATCH=NBATCH,NHEAD=NHEADS,SEQ=SEQLEN,D=64,DM=NHEAD*D,ODM=1024;
constexpr int NW=8,QBLK=32,QB=QBLK*NW,KVBLK=64,NQB=SEQ/QB;
__device__ __forceinline__ int crow(int r,int hi){return (r&3)+8*(r>>2)+4*hi;}
#define SBAR() __builtin_amdgcn_sched_barrier(0)
__device__ __forceinline__ void cmask(f32x16&p0,f32x16&p1,int jb,int qrel,int hi){
  const float NEG=-INFINITY; int kb=64*jb+4*hi;
  #pragma unroll
  for(int r=0;r<16;++r){int kv=kb+(r&3)+8*(r>>2); if(kv>qrel)p0[r]=NEG; if(kv+32>qrel)p1[r]=NEG;}
}
constexpr int NSLOT=3, SLOTB=8192;
constexpr int LDS_K=0, LDS_V=NSLOT*SLOTB, LDS_WS=2*NSLOT*SLOTB, LDS_OST=LDS_WS+NW*64*4, LDS_KB=LDS_OST+NW*4096, LDS_BYTES=LDS_KB+SEQ*4;
constexpr float C2=0.125f*1.4426950408889634f;
__device__ __forceinline__ void glds16(const void*gsrc,unsigned lds_dst){unsigned keep;
  asm volatile("s_mov_b32 %0, m0\n\ts_mov_b32 m0, %2\n\ts_nop 0\n\tglobal_load_lds_dwordx4 %1, off\n\ts_mov_b32 m0, %0":"=&s"(keep):"v"(gsrc),"s"(lds_dst):"memory");}
__device__ __forceinline__ float max3f(float a,float b,float c){float r;asm("v_max3_f32 %0, %1, %2, %3":"=v"(r):"v"(a),"v"(b),"v"(c));return r;}
__device__ __forceinline__ float max2f(float a,float b){float r;asm("v_max_f32_e32 %0, %1, %2":"=v"(r):"v"(a),"v"(b));return r;}
__device__ __forceinline__ float fadd_s(float a,float b){float r;asm("v_add_f32_e32 %0, %1, %2":"=v"(r):"v"(a),"v"(b));return r;}
__device__ __forceinline__ float fsub_s(float a,float b){float r;asm("v_sub_f32_e32 %0, %1, %2":"=v"(r):"v"(a),"v"(b));return r;}
typedef float f32x2_t __attribute__((ext_vector_type(2))); typedef __bf16 bf16x2_t __attribute__((ext_vector_type(2)));
__device__ __forceinline__ unsigned cvtpk_s(float lo,float hi){f32x2_t v={lo,hi};bf16x2_t b=__builtin_convertvector(v,bf16x2_t);return __builtin_bit_cast(unsigned,b);}
#define WAIT_BAR(N) asm volatile("s_waitcnt vmcnt(" #N ") lgkmcnt(0)\n\ts_barrier":::"memory")

__device__ __forceinline__ void qkt(f32x16&p0,f32x16&p1,const char*Kslot,const bf16x8*qr,int r32,int hi){
  const char*kb=Kslot+hi*1024+r32*16;
  #pragma unroll
  for(int d0=0;d0<4;++d0){
    const bf16x8 b0=*reinterpret_cast<const bf16x8*>(kb+d0*2048);
    const bf16x8 b1=*reinterpret_cast<const bf16x8*>(kb+d0*2048+512);
    p0=__builtin_amdgcn_mfma_f32_32x32x16_bf16(b0,qr[d0],p0,0,0,0);p1=__builtin_amdgcn_mfma_f32_32x32x16_bf16(b1,qr[d0],p1,0,0,0);}
}
typedef __attribute__((address_space(3))) const char* lds_cptr;
typedef short v4i16_t __attribute__((ext_vector_type(4)));
__device__ __forceinline__ void kload8(bf16x8*kf,lds_cptr kp){
  kf[0]=*(const __attribute__((address_space(3))) bf16x8*)(kp);      kf[1]=*(const __attribute__((address_space(3))) bf16x8*)(kp+512);
  kf[2]=*(const __attribute__((address_space(3))) bf16x8*)(kp+2048); kf[3]=*(const __attribute__((address_space(3))) bf16x8*)(kp+2560);
  kf[4]=*(const __attribute__((address_space(3))) bf16x8*)(kp+4096); kf[5]=*(const __attribute__((address_space(3))) bf16x8*)(kp+4608);
  kf[6]=*(const __attribute__((address_space(3))) bf16x8*)(kp+6144); kf[7]=*(const __attribute__((address_space(3))) bf16x8*)(kp+6656);
}
__device__ __forceinline__ void kload2(bf16x8*kf,lds_cptr kp,int j){ kf[2*j]=*(const __attribute__((address_space(3))) bf16x8*)(kp+j*2048); kf[2*j+1]=*(const __attribute__((address_space(3))) bf16x8*)(kp+j*2048+512); }
__device__ __forceinline__ s16x4 vtr(lds_cptr p){ return __builtin_bit_cast(s16x4,__builtin_amdgcn_ds_read_tr16_b64_v4i16((__attribute__((address_space(3))) v4i16_t*)p)); }
__device__ __forceinline__ float rowmax(const f32x16&p0,const f32x16&p1){
  float a=max3f(p0[0],p0[1],p1[0]),b=max3f(p0[2],p0[3],p1[1]);a=max3f(a,p1[2],p1[3]);
  #pragma unroll
  for(int r=4;r<16;r+=4){a=max3f(a,p0[r],p0[r+1]);b=max3f(b,p0[r+2],p0[r+3]);a=max3f(a,p1[r],p1[r+1]);b=max3f(b,p1[r+2],p1[r+3]);}
  const float m=max2f(a,b);
  auto rr=__builtin_amdgcn_permlane32_swap(__float_as_uint(m),__float_as_uint(m),false,false);
  return max2f(__uint_as_float(rr[0]),__uint_as_float(rr[1]));
}
__device__ __forceinline__ void pv(f32x16*o,int vb,bf16x8 pa0,bf16x8 pa1,bf16x8 pa2,bf16x8 pa3){
  #pragma unroll
  for(int d0=0;d0<2;++d0){s16x4 lo[4],hi[4];
    #pragma unroll
    for(int ks=0;ks<4;++ks){
      asm volatile("ds_read_b64_tr_b16 %0,%1 offset:%c2":"=&v"(lo[ks]):"v"(vb),"i"(d0*4096+ks*1024):"memory");
      asm volatile("ds_read_b64_tr_b16 %0,%1 offset:%c2":"=&v"(hi[ks]):"v"(vb),"i"(d0*4096+ks*1024+512):"memory");}
    asm volatile("s_waitcnt lgkmcnt(0)":::"memory");SBAR();
    #define PK(k) (bf16x8){lo[k][0],lo[k][1],lo[k][2],lo[k][3],hi[k][0],hi[k][1],hi[k][2],hi[k][3]}
    o[d0]=__builtin_amdgcn_mfma_f32_32x32x16_bf16(pa0,PK(0),o[d0],0,0,0);
    o[d0]=__builtin_amdgcn_mfma_f32_32x32x16_bf16(pa1,PK(1),o[d0],0,0,0);
    o[d0]=__builtin_amdgcn_mfma_f32_32x32x16_bf16(pa2,PK(2),o[d0],0,0,0);
    o[d0]=__builtin_amdgcn_mfma_f32_32x32x16_bf16(pa3,PK(3),o[d0],0,0,0);
    #undef PK
  }
}
#define ATTN_STORE16(p,v) (*(u32x4*)(p)=(v))
template<int THRL> __device__ __forceinline__ void attn_unit(int b,int h,int qb,const bf16*Q,const bf16*__restrict__ K,const bf16*__restrict__ V,bf16*O,char*shm,bf16x8(&qr)[4]){
  int tid=threadIdx.x; asm volatile("":"+v"(tid));
  const int lane=tid&63,r32=lane&31,hi=lane>>5; const int wid=__builtin_amdgcn_readfirstlane(tid>>6);
  const long rowbase=(long)b*SEQ; const int q0=qb*QB;
  const bf16*Qw=Q+(rowbase+q0+wid*QBLK)*DM+h*D;
  const bf16*Kh=K+rowbase*DM+h*D,*Vh=V+rowbase*DM+h*D;
  const unsigned lds0=(unsigned)(uintptr_t)shm;
  float*wsf=(float*)(shm+LDS_WS)+wid*64;
  const bf16*ksrc=Kh+(long)lane*DM+wid*8;
  const bf16*vsrc=Vh+(long)(16*(wid&3)+(lane>>2))*DM+(wid>>2)*32+(lane&3)*8;
  const unsigned kdst=lds0+LDS_K+wid*1024, vdst=lds0+LDS_V+wid*1024;
  #define DMA_K(t,slot) glds16(ksrc+(long)(t)*KVBLK*DM,(unsigned)__builtin_amdgcn_readfirstlane(kdst+(slot)))
  #define DMA_V(t,slot) glds16(vsrc+(long)(t)*KVBLK*DM,(unsigned)__builtin_amdgcn_readfirstlane(vdst+(slot)))
  const int vb0=(int)(lds0+LDS_V)+((lane>>4)&1)*32+(lane&3)*8+(4*hi+((lane&15)>>2))*64;
  const char*Kbase=shm+LDS_K; bf16x8 kf[8];
  const lds_cptr shm3=(lds_cptr)shm; const lds_cptr kp0=shm3+LDS_K+hi*1024+r32*16; const lds_cptr vp0=shm3+LDS_V+((lane>>4)&1)*32+(lane&3)*8+(4*hi+((lane&15)>>2))*64;
  const lds_cptr kbp=shm3+LDS_KB+hi*16;
  const int NT=(q0+QB)/KVBLK;
  if(qb==NQB-1){DMA_K(0,0);DMA_V(0,0);DMA_K(1,SLOTB);}
  if(qb==NQB-1){
    #pragma unroll
    for(int d0=0;d0<4;++d0)qr[d0]=*reinterpret_cast<const bf16x8*>(&Qw[(long)r32*DM+d0*16+hi*8]); }
  float mhat=0.f,l_reg=0.f;f32x16 o[2];o[0]=f32x16{};o[1]=f32x16{};
  const int qrel=wid*QBLK+r32;
  #define CINIT(X0,X1,tt) do{ const lds_cptr p_=kbp+(tt)*256; \
    _Pragma("unroll") for(int g_=0;g_<4;++g_){ \
      const f32x4v a_=*(const __attribute__((address_space(3))) f32x4v*)(p_+32*g_); const f32x4v b_=*(const __attribute__((address_space(3))) f32x4v*)(p_+128+32*g_); \
      X0[4*g_]=a_[0]-mhat; X0[4*g_+1]=a_[1]-mhat; X0[4*g_+2]=a_[2]-mhat; X0[4*g_+3]=a_[3]-mhat; \
      X1[4*g_]=b_[0]-mhat; X1[4*g_+1]=b_[1]-mhat; X1[4*g_+2]=b_[2]-mhat; X1[4*g_+3]=b_[3]-mhat; } }while(0)
  #define CMASK(P0,P1,t) do{int jb_=(t)-(NT-4); if(jb_>=0)cmask(P0,P1,jb_,qrel,hi);}while(0)
  bool resc=false;
  #define START(P0,P1) do{ const float rm=rowmax(P0,P1); resc=false; \
    { const float dl=rm; mhat=fadd_s(mhat,dl); \
      _Pragma("unroll") for(int r=0;r<16;++r){P0[r]=fsub_s(P0[r],dl);P1[r]=fsub_s(P1[r],dl);} } \
    _Pragma("unroll") for(int r=0;r<16;++r)P0[r]=__builtin_amdgcn_exp2f(P0[r]); }while(0)
  #define RESC() do{ if(resc){ asm volatile("s_waitcnt lgkmcnt(0)":::"memory"); \
      _Pragma("unroll") for(int d_=0;d_<2;++d_) _Pragma("unroll") for(int r=0;r<16;++r)o[d_][r]*=wsf[crow(r,hi)]; } }while(0)
  f32x16 pA0,pA1,pB0,pB1;
  int sl_prev=0,sl_cur=0,sl_next=SLOTB;
  #define ROT() do{sl_prev=sl_cur;sl_cur=sl_next;sl_next=(sl_next==(NSLOT-1)*SLOTB)?0:sl_next+SLOTB;}while(0)
  DMA_K(2,2*SLOTB);
  CINIT(pA0,pA1,0);
  WAIT_BAR(3);
  qkt(pA0,pA1,Kbase,qr,r32,hi);asm volatile("s_nop 15\n\ts_nop 7":"+v"(pA0),"+v"(pA1));CMASK(pA0,pA1,0);
  START(pA0,pA1);
  _Pragma("unroll") for(int r=0;r<16;++r)pA1[r]=__builtin_amdgcn_exp2f(pA1[r]);
  CINIT(pB0,pB1,1);
  WAIT_BAR(0);
  DMA_K(3,0);DMA_V(1,SLOTB);
  ROT();
  kload8(kf,kp0+sl_cur);
  WAIT_BAR(2);
  s16x4 vlo[8],vhi[8]; u32x4 pw0,pw1,pw2,pw3;
  #define PKW(P,B) cvtpk_s(P[B],P[B+1])
  #define PAF(k) __builtin_bit_cast(bf16x8,pw##k)
  #define VFR(i) (bf16x8){vlo[i][0],vlo[i][1],vlo[i][2],vlo[i][3],vhi[i][0],vhi[i][1],vhi[i][2],vhi[i][3]}
  #define PIN(x) asm volatile("":"+v"(x))
  #define MX3(a,b,c) __builtin_fmaxf(__builtin_fmaxf((a),(b)),(c))
  #define GAPA(MF,A0,A1,A2,A3,W0,W1,PW) do{ MF; sacc+=A0; sacc+=A1; sacc+=A2; sacc+=A3; PIN(sacc); W0; W1; PIN(PW); SBAR(); }while(0)
  #define EX(v) __builtin_amdgcn_exp2f(v)
  #define GAPB(MF,X,B) do{ MF; X[B]=EX(X[B]); X[B+1]=EX(X[B+1]); X[B+2]=EX(X[B+2]); X[B+3]=EX(X[B+3]); PIN(X); SBAR(); }while(0)
  #define VRD(i) do{ vlo[i]=vtr(vp_+(((i)>>2)*4096+((i)&3)*1024)); vhi[i]=vtr(vp_+(((i)>>2)*4096+((i)&3)*1024+512)); }while(0)
  #define KRD(G,j) do{ if(G){ kload2(kf,kp0+sl_next,j); SBAR(); } }while(0)
  #define STEP(C0,C1,P0,P1,t,GK,GV,GL) do{ SBAR(); \
    const lds_cptr vp_=vp0+sl_prev; \
    VRD(0); SBAR(); float sacc=(P0[0]+P0[1]); \
    GAPA(C0=__builtin_amdgcn_mfma_f32_32x32x16_bf16(kf[0],qr[0],C0,0,0,0), P0[2],P0[3],P0[4],P0[5],     pw0[0]=PKW(P0,0), pw0[1]=PKW(P0,2), pw0); \
    VRD(4); SBAR(); GAPA(C1=__builtin_amdgcn_mfma_f32_32x32x16_bf16(kf[1],qr[0],C1,0,0,0), P0[6],P0[7],P0[8],P0[9],     pw0[2]=PKW(P0,4), pw0[3]=PKW(P0,6), pw0); \
    VRD(1); SBAR(); GAPA(C0=__builtin_amdgcn_mfma_f32_32x32x16_bf16(kf[2],qr[1],C0,0,0,0),   P0[10],P0[11],P0[12],P0[13], pw1[0]=PKW(P0,8), pw1[1]=PKW(P0,10), pw1); \
    VRD(5); SBAR(); GAPA(C1=__builtin_amdgcn_mfma_f32_32x32x16_bf16(kf[3],qr[1],C1,0,0,0),   P0[14],P0[15],P1[0],P1[1],   pw1[2]=PKW(P0,12),pw1[3]=PKW(P0,14), pw1); \
    VRD(2); SBAR(); GAPA(C0=__builtin_amdgcn_mfma_f32_32x32x16_bf16(kf[4],qr[2],C0,0,0,0),   P1[2],P1[3],P1[4],P1[5],     pw2[0]=PKW(P1,0), pw2[1]=PKW(P1,2), pw2); \
    VRD(6); SBAR(); GAPA(C1=__builtin_amdgcn_mfma_f32_32x32x16_bf16(kf[5],qr[2],C1,0,0,0),   P1[6],P1[7],P1[8],P1[9],     pw2[2]=PKW(P1,4), pw2[3]=PKW(P1,6), pw2); \
    VRD(3); SBAR(); GAPA(C0=__builtin_amdgcn_mfma_f32_32x32x16_bf16(kf[6],qr[3],C0,0,0,0),   P1[10],P1[11],P1[12],P1[13], pw3[0]=PKW(P1,8), pw3[1]=PKW(P1,10), pw3); \
    VRD(7); SBAR(); GAPA(C1=__builtin_amdgcn_mfma_f32_32x32x16_bf16(kf[7],qr[3],C1,0,0,0),   P1[14],P1[15],0.f,0.f,       pw3[2]=PKW(P1,12),pw3[3]=PKW(P1,14), pw3); \
    l_reg+=sacc; \
    if(GK){DMA_K((t)+3,sl_cur);} if(GV){DMA_V((t)+1,sl_next);} \
    CMASK(C0,C1,t); \
    { float a=MX3(C0[0],C0[1],C1[0]),b=MX3(C0[2],C0[3],C1[1]); a=MX3(a,C1[2],C1[3]); \
      _Pragma("unroll") for(int r=4;r<16;r+=4){a=MX3(a,C0[r],C0[r+1]);b=MX3(b,C0[r+2],C0[r+3]);a=MX3(a,C1[r],C1[r+1]);b=MX3(b,C1[r+2],C1[r+3]);} \
      float rm=__builtin_fmaxf(a,b); { auto rr=__builtin_amdgcn_permlane32_swap(__float_as_uint(rm),__float_as_uint(rm),false,false); rm=__builtin_fmaxf(__uint_as_float(rr[0]),__uint_as_float(rr[1])); } \
      resc=false; \
      if(__builtin_expect(__any(rm>(float)THRL),0)){ const float dl=__builtin_fmaxf(rm,0.f); mhat+=dl; \
        _Pragma("unroll") for(int r=0;r<16;++r){C0[r]-=dl;C1[r]-=dl;} \
        const float f=__builtin_amdgcn_exp2f(-dl); l_reg*=f; if(hi==0)wsf[r32]=f; resc=true; } } \
    SBAR(); \
    GAPB(o[0]=__builtin_amdgcn_mfma_f32_32x32x16_bf16(PAF(0),VFR(0),o[0],0,0,0), C0,0); \
    GAPB(o[1]=__builtin_amdgcn_mfma_f32_32x32x16_bf16(PAF(0),VFR(4),o[1],0,0,0), C0,4); \
    KRD(GL,0); GAPB(o[0]=__builtin_amdgcn_mfma_f32_32x32x16_bf16(PAF(1),VFR(1),o[0],0,0,0), C0,8); \
    KRD(GL,1); GAPB(o[1]=__builtin_amdgcn_mfma_f32_32x32x16_bf16(PAF(1),VFR(5),o[1],0,0,0), C0,12); \
    KRD(GL,2); GAPB(o[0]=__builtin_amdgcn_mfma_f32_32x32x16_bf16(PAF(2),VFR(2),o[0],0,0,0), C1,0); \
    KRD(GL,3); GAPB(o[1]=__builtin_amdgcn_mfma_f32_32x32x16_bf16(PAF(2),VFR(6),o[1],0,0,0), C1,4); \
    GAPB(o[0]=__builtin_amdgcn_mfma_f32_32x32x16_bf16(PAF(3),VFR(3),o[0],0,0,0), C1,8); \
    GAPB(o[1]=__builtin_amdgcn_mfma_f32_32x32x16_bf16(PAF(3),VFR(7),o[1],0,0,0), C1,12); \
    if(GL){ CINIT(P0,P1,(t)+1); } \
    }while(0)
  int t=1;
  #undef CMASK
  #define CMASK(P0,P1,t) do{}while(0)
  for(;t+5<NT;t+=2){
    STEP(pB0,pB1,pA0,pA1,t,true,true,true);     WAIT_BAR(2); RESC(); ROT();
    STEP(pA0,pA1,pB0,pB1,t+1,true,true,true);   WAIT_BAR(2); RESC(); ROT();
  }
  #undef CMASK
  #define CMASK(P0,P1,t) do{int jb_=(t)-(NT-4); if(jb_>=0)cmask(P0,P1,jb_,qrel,hi);}while(0)
  #define ENDW(tt) do{ if((tt)+3<NT){WAIT_BAR(2);} else if((tt)+2<NT){WAIT_BAR(1);} else {WAIT_BAR(0);} }while(0)
  for(;t+1<NT;t+=2){
    STEP(pB0,pB1,pA0,pA1,t,(t+3<NT),(t+1<NT),(t+1<NT));       ENDW(t);   RESC(); ROT();
    STEP(pA0,pA1,pB0,pB1,t+1,(t+4<NT),(t+2<NT),(t+2<NT));     ENDW(t+1); RESC(); ROT();
  }
  STEP(pB0,pB1,pA0,pA1,NT-1,false,false,false); RESC();
  { float sacc=pB0[0]+pB0[1]; _Pragma("unroll") for(int r=2;r<16;++r)sacc+=pB0[r]; _Pragma("unroll") for(int r=0;r<16;++r)sacc+=pB1[r]; l_reg+=sacc;
    pw0=(u32x4){PKW(pB0,0),PKW(pB0,2),PKW(pB0,4),PKW(pB0,6)};pw1=(u32x4){PKW(pB0,8),PKW(pB0,10),PKW(pB0,12),PKW(pB0,14)};pw2=(u32x4){PKW(pB1,0),PKW(pB1,2),PKW(pB1,4),PKW(pB1,6)};pw3=(u32x4){PKW(pB1,8),PKW(pB1,10),PKW(pB1,12),PKW(pB1,14)};
    SBAR(); pv(o,vb0+sl_cur,PAF(0),PAF(1),PAF(2),PAF(3)); }
  if(qb>0){ asm volatile("s_barrier":::"memory"); DMA_K(0,0);DMA_V(0,0);DMA_K(1,SLOTB);
    const bf16*Qn=Qw-(long)QB*DM;
    #pragma unroll
    for(int d0=0;d0<4;++d0)qr[d0]=*reinterpret_cast<const bf16x8*>(&Qn[(long)r32*DM+d0*16+hi*8]); }
  #undef PKW
  #undef PAF
  #undef VFR
  #undef PIN
  #undef MX3
  #undef GAPA
  #undef GAPB
  #undef EX
  #undef VRD
  #undef KRD
  #undef STEP
  #undef ENDW
  {auto rr=__builtin_amdgcn_permlane32_swap(__float_as_uint(l_reg),__float_as_uint(l_reg),false,false);l_reg=__uint_as_float(rr[0])+__uint_as_float(rr[1]);}
  if(hi==0)wsf[32+r32]=l_reg;asm volatile("s_waitcnt lgkmcnt(0)":::"memory");
  float rli[16];
  #pragma unroll
  for(int r=0;r<16;++r)rli[r]=__builtin_amdgcn_rcpf(wsf[32+crow(r,hi)]);
  bf16*Ow=O+(rowbase+q0+wid*QBLK)*ODM+h*D;
  { bf16*stg=(bf16*)(shm+LDS_OST)+wid*2048;
    #pragma unroll
    for(int r=0;r<16;++r){const int orow=crow(r,hi);
      #pragma unroll
      for(int d0=0;d0<2;++d0)stg[orow*64+d0*32+r32]=__float2bfloat16(o[d0][r]*rli[r]);}
    asm volatile("s_waitcnt lgkmcnt(0)":::"memory");
    #pragma unroll
    for(int i=0;i<4;++i){const int row=i*8+(lane>>3),ch=lane&7; const u32x4 v=*(const u32x4*)(stg+row*64+ch*8); ATTN_STORE16(Ow+(long)row*ODM+ch*8,v);} }
  asm volatile("s_waitcnt lgkmcnt(0)\n\ts_barrier":::"memory");
  #undef DMA_K
  #undef DMA_V
  #undef CMASK
  #undef CINIT
  #undef START
  #undef RESC
  #undef ROT
}
#undef SBAR
#undef WAIT_BAR
}

constexpr size_t MiB = 1u << 20;
constexpr size_t WS_CTL = 0, CTL_ZERO_BYTES = 96 * 1024;
constexpr size_t WS_WIN = 2 * MiB;
constexpr size_t WS_W3 = 12 * MiB;
constexpr size_t WS_WOUT = 14 * MiB;
constexpr size_t WS_WGU = 16 * MiB;
constexpr size_t WS_WD = 80 * MiB;
constexpr size_t WS_H = 112 * MiB;
constexpr size_t WS_CB = 240 * MiB;
constexpr size_t WS_UC = 304 * MiB;
constexpr size_t WS_MIX = 688 * MiB;
constexpr size_t WS_Q = 368 * MiB, WS_K = 432 * MiB, WS_V = 496 * MiB;
constexpr size_t WS_R = 560 * MiB;
constexpr size_t WS_G8 = WS_R;
constexpr size_t WS_ACT = 304 * MiB;
constexpr size_t WS_Y = 568 * MiB;
constexpr size_t WS_H8 = 816 * MiB;
constexpr size_t WS_WG8 = 880 * MiB;
constexpr size_t WS_X1B = 112 * MiB;
constexpr size_t WS_H2 = 240 * MiB;
constexpr size_t WS_LOGF = 968 * MiB;
constexpr size_t WS_LIST = 970 * MiB;
constexpr size_t WS_TOKSLOT = 986 * MiB;
constexpr size_t WS_TOKW = 987 * MiB;
constexpr size_t WS_END = 988 * MiB;
static_assert(WS_H2 + (size_t)NTOK * 1024 <= WS_ACT && WS_ACT + (size_t)1056 * 256 * 1024 <= WS_Y && WS_Y + (size_t)1056 * 256 * 1024 <= WS_LOGF && WS_X1B + (size_t)NTOK * 2048 <= WS_H2 && WS_H2 == WS_CB && WS_X1B == WS_H, "MoE buffers");
constexpr int CW_BAR = 4096;
constexpr int CW_CNT = 16384;
constexpr int CW_CVT = 20480;
constexpr int CVT_NGU = 32 * 8 * 64 / 8;
constexpr int CVT_NCH = CVT_NGU + 32 * 8 * 32 / 8;
#ifndef CVT_STOP
#define CVT_STOP 3u
#endif

constexpr int RING_OFF = 0, RING_BYTES = 131072;
constexpr int LDSCTL_OFF = RING_BYTES, MISC_OFF = LDSCTL_OFF + 320;
constexpr int MOETAB_OFF = LDSCTL_OFF + 1024;
constexpr int P5_OFF = LDSCTL_OFF + 2048;
constexpr int GAUX_OFF = LDSCTL_OFF + 8192;
constexpr int LDS_BYTES = 147456;
static_assert(P5_OFF + (64 + 1024) * 4 <= GAUX_OFF && GAUX_OFF + 8192 <= LDS_BYTES && attn_body::LDS_BYTES <= RING_BYTES, "LDS map");

#define GAS __attribute__((address_space(1)))
#define LAS __attribute__((address_space(3)))
typedef unsigned short bf16;
typedef unsigned v4u __attribute__((ext_vector_type(4)));
typedef unsigned v2u __attribute__((ext_vector_type(2)));
typedef float f32x4 __attribute__((ext_vector_type(4)));
typedef GAS unsigned gu32;
#define RLX_AGENT __ATOMIC_RELAXED, __HIP_MEMORY_SCOPE_AGENT
#define LDS_WAIT() asm volatile("s_waitcnt lgkmcnt(0)" ::: "memory")
#define VM_WAIT() asm volatile("s_waitcnt vmcnt(0)" ::: "memory")
__device__ __forceinline__ unsigned f2bf(float f) { unsigned u = __builtin_bit_cast(unsigned, f); return (u + 0x7fffu + ((u >> 16) & 1u)) >> 16; }
__device__ __forceinline__ unsigned pk2(float lo, float hi) { return f2bf(lo) | (f2bf(hi) << 16); }

#define XB_TMO      128
#define XB_MISMAP   192
#define XB_XCNT(j)  (256  + 64 * (j))
#define XB_XSUB(j)  (1280 + 64 * (j))
#define XB_XGEN(j)  (2304 + 64 * (j))
#define XB_TOP      3328
#define XB_TOPGEN   3392
#define XCD_BAR_WORDS 3456
#define XB_SPIN_CAP (1u << 18)
__device__ __forceinline__ unsigned xb_ld(unsigned* p)              { return __hip_atomic_load(p, __ATOMIC_RELAXED, __HIP_MEMORY_SCOPE_AGENT); }
__device__ __forceinline__ unsigned xb_add(unsigned* p, unsigned v) { return __hip_atomic_fetch_add(p, v, __ATOMIC_RELAXED, __HIP_MEMORY_SCOPE_AGENT); }
__device__ __forceinline__ unsigned xb_xcc_id() { return (unsigned)__builtin_amdgcn_s_getreg((3 << 11) | 20) & 0xFu; }
#define XB_SPIN(cond, bar) do { unsigned _sp = 0; while (cond) { __builtin_amdgcn_s_sleep(1); \
    if ((++_sp & 255u) == 0u) { if (xb_ld(&(bar)[XB_TMO])) break; if (_sp > XB_SPIN_CAP) { atomicAdd(&(bar)[XB_TMO], 1u); break; } } } } while (0)
struct XcdBarrier { unsigned* bar; unsigned x; volatile LAS unsigned* st; };
__device__ __forceinline__ XcdBarrier xcd_barrier_post(unsigned* bar, volatile LAS unsigned* st) {
    XcdBarrier b; b.bar = bar; b.x = xb_xcc_id(); b.st = st;
    if (threadIdx.x == 0) {
        if (b.x != (blockIdx.x & 7u)) { const unsigned r = xb_add(&bar[XB_MISMAP], 1u); asm volatile("" :: "v"(r)); }
        (void)xb_add(&bar[XB_XCNT(b.x)], 1u);
    }
    return b;
}
__device__ __forceinline__ void xcd_barrier_complete(unsigned* bar, unsigned x, unsigned& nloc, unsigned& nx) {
    const unsigned G = gridDim.x * gridDim.y * gridDim.z;
    unsigned sum, cnt, mine, even, sp = 0u;
    for (;;) {
        sum = 0u; cnt = 0u; mine = 0u; even = 1u;
#pragma unroll
        for (unsigned j = 0; j < 16; ++j) { const unsigned c = xb_ld(&bar[XB_XCNT(j)]); sum += c; cnt += (c > 0u) ? 1u : 0u; mine = (j == x) ? c : mine; even &= (c == (j < 8u ? G / 8u : 0u)) ? 1u : 0u; }
        if (sum == G) break;
        __builtin_amdgcn_s_sleep(1);
        if ((++sp & 255u) == 0u) { if (xb_ld(&bar[XB_TMO])) break; if (sp > XB_SPIN_CAP) { atomicAdd(&bar[XB_TMO], 1u); break; } }
    }
    nloc = mine > 0u ? mine : 1u; nx = cnt > 0u ? cnt : 1u;
    if (even && G == 256u && (G & 7u) == 0u && xb_ld(&bar[XB_MISMAP]) == 0u && xb_ld(&bar[XB_TMO]) == 0u) nx |= 0x10000u;
}
__device__ __forceinline__ void xcd_barrier(const XcdBarrier& b) {
    asm volatile("s_waitcnt vmcnt(0)" ::: "memory");
    __syncthreads();
    if (threadIdx.x == 0) {
        unsigned* bar = b.bar;
        __builtin_amdgcn_s_waitcnt(0);
        unsigned nloc = b.st[0], nx = b.st[1];
        if (nloc == 0u) { xcd_barrier_complete(bar, b.x, nloc, nx); b.st[0] = nloc; b.st[1] = nx; }
        nx &= 0xffffu;
        const unsigned old = xb_add(&bar[XB_XSUB(b.x)], 1u);
        const unsigned gen = old / nloc;
        if (old + 1u == (gen + 1u) * nloc) {
            __builtin_amdgcn_fence(__ATOMIC_RELEASE, "agent");
            asm volatile("s_waitcnt vmcnt(0)" ::: "memory");
            const unsigned og = xb_add(&bar[XB_TOP], 1u);
            const unsigned tg = og / nx;
            if (og + 1u == (tg + 1u) * nx) xb_add(&bar[XB_TOPGEN], 1u);
            else XB_SPIN(xb_ld(&bar[XB_TOPGEN]) == tg, bar);
            __builtin_amdgcn_fence(__ATOMIC_ACQUIRE, "agent");
            xb_add(&bar[XB_XGEN(b.x)], 1u);
            asm volatile("s_waitcnt vmcnt(0)" ::: "memory");
        } else {
            XB_SPIN(xb_ld(&bar[XB_XGEN(b.x)]) == gen, bar);
            __builtin_amdgcn_fence(__ATOMIC_ACQUIRE, "agent");
            asm volatile("s_waitcnt vmcnt(0)" ::: "memory");
        }
    }
    __syncthreads();
}

struct Args {
    const float *x, *g_mix, *w_in, *conv_w, *b_f, *w_conv_o, *w_attn_o, *w_out, *g_ffn, *w_router, *b_router, *w_gate_up, *b_gate_up, *w_down, *b_down, *g_final;
    float* out; unsigned char* ws; int ph_lo, ph_hi, li, pad;
};
struct Frame {
    LAS unsigned char* lds;
    int tid, lane, wave, vcu, G, bx;
};
__device__ __forceinline__ float wave_sum(float v) {
#pragma unroll
    for (int o = 1; o < 64; o <<= 1) v += __shfl_xor(v, o);
    return v;
}

struct SchedGrid {
    pg8::GridOrder o; unsigned A, B, atile, btile; int i0 = 0, i1 = 1 << 30;
    __device__ __forceinline__ bool next(int i, pg8::Unit& u) const { int pm, pn; if (i + i0 >= i1 || !o.map(i + i0, pm, pn)) return false;
        u.A = A + (unsigned)pm * atile; u.B = B + (unsigned)pn * btile; u.rows = 0u; u.pm = pm; u.pn = pn; u.e = 0; u.nvalid = 256; u.lrows = 0; return true; }
};
struct SchedMix {
    pg8::GridOrder o; unsigned A, B, atile, btile;
    __device__ __forceinline__ bool next(int i, pg8::Unit& u) const { int pm, pn; if (!o.map(i >> 1, pm, pn)) return false; const int hf = i & 1;
        u.A = A + (unsigned)pm * atile + hf * 1024u; u.B = B + (unsigned)pn * btile + hf * 1024u; u.rows = 0u; u.pm = pm; u.pn = pn; u.e = hf; u.nvalid = 256; u.lrows = 0; return true; }
};
struct SchedMoe {
    const LAS int* tab; int G, c, nct, gather; unsigned A, B, list, bexp, atile, btile;
    __device__ __forceinline__ bool next(int i, pg8::Unit& u) const {
        const int total = __builtin_amdgcn_readfirstlane(tab[32]); const long L = (long)i * G + c; if (L >= total) return false;
        int wgid = (int)L; { const int q = total / 8, r = total % 8, xcd = wgid % 8, off = wgid / 8; wgid = (xcd < r ? xcd * (q + 1) : r * (q + 1) + (xcd - r) * q) + off; }
        int tl_ = threadIdx.x; asm volatile("" : "+v"(tl_));
        const int ub1 = tab[(tl_ & 31) + 1];
        const unsigned long long mk = __ballot(wgid < ub1);
        const int e = __builtin_amdgcn_readfirstlane((int)__builtin_ctzll(mk)) & 31;
        const int l = wgid - __builtin_amdgcn_readfirstlane(tab[e]), nM = __builtin_amdgcn_readfirstlane(tab[64 + e]), pt = __builtin_amdgcn_readfirstlane(tab[96 + e]), cnt = __builtin_amdgcn_readfirstlane(tab[128 + e]);
        const int nig = 8 * nct, gid = l / nig, fm = gid * 8, gsz = (nM - fm) < 8 ? (nM - fm) : 8;
        const int rt = fm + ((l % nig) % gsz), ct = (l % nig) / gsz;
        u.e = e; u.pm = pt + rt; u.pn = ct; u.lrows = 0;
        u.B = B + (unsigned)e * bexp + (unsigned)ct * btile;
        if (gather) { u.A = A; u.rows = list + (unsigned)(e * LISTCAP + rt * 256) * 8u; const int nv = cnt - rt * 256; u.nvalid = nv < 256 ? nv : 256; }
        else { u.A = A + (unsigned)(pt + rt) * atile; u.rows = 0u; u.nvalid = 256; }
        return true;
    }
};

using pg8::f32x2; using pg8::u32x4; using pg8::cvt_pk_bf16; using pg8::bf_lo; using pg8::bf_hi;
__device__ __forceinline__ u32x4 pack8(const f32x4 a, const f32x4 b) { u32x4 w; w.x = cvt_pk_bf16(a[0], a[1]); w.y = cvt_pk_bf16(a[2], a[3]); w.z = cvt_pk_bf16(b[0], b[1]); w.w = cvt_pk_bf16(b[2], b[3]); return w; }
__device__ __forceinline__ float fast_exp(float x) { return __builtin_amdgcn_exp2f(x * 1.4426950408889634f); }
__device__ __forceinline__ unsigned pk4_fp8(float a, float b, float c, float d) { int w = __builtin_amdgcn_cvt_pk_fp8_f32(a, b, 0, false); w = __builtin_amdgcn_cvt_pk_fp8_f32(c, d, w, true); return (unsigned)w; }

#define EPI_COORDS() int tid_ = threadIdx.x; asm volatile("" : "+v"(tid_)); const int lane_ = tid_ & 63, wid_ = __builtin_amdgcn_readfirstlane(tid_ >> 6); \
    const int wr = wid_ >> 2, wc = wid_ & 3, fr = lane_ & 15, fq = lane_ >> 4
struct EpiG1 {
    static constexpr bool PERM = true; static constexpr bool BIAS_LDS = false;
    unsigned char* ws; float qscale;
    __device__ __forceinline__ bool operator()(f32x4 (&acc)[2][2][4][2], const pg8::Unit& u) const {
        EPI_COORDS();
        const int row0 = u.pm * 256 + wr * 64 + fr, cl = wc * 32 + 8 * fq, pn = u.pn;
        if (pn < 2 || (pn >= 6 && pn < 12)) {
            size_t boff; int colt; float sc = 1.f;
            if (pn < 2) { boff = WS_CB; colt = pn * 256; }
            else { const int t = (pn - 6) >> 1; boff = WS_Q + (size_t)t * (WS_K - WS_Q); colt = ((pn - 6) & 1) * 256; if (t == 0) sc = qscale; }
            bf16* base = (bf16*)(ws + boff);
#pragma unroll
            for (int ai = 0; ai < 2; ++ai)
#pragma unroll
                for (int m = 0; m < 4; ++m) { bf16* rowp = base + (size_t)(row0 + ai * 128 + m * 16) * 512 + colt + cl;
#pragma unroll
                    for (int bj = 0; bj < 2; ++bj) *(u32x4*)(rowp + bj * 128) = pack8(acc[ai][bj][m][0] * sc, acc[ai][bj][m][1] * sc); }
        } else {
            const int T = pn - 2; bf16* UC = (bf16*)(ws + WS_UC);
#pragma unroll
            for (int ai = 0; ai < 2; ++ai)
#pragma unroll
                for (int m = 0; m < 4; ++m) { bf16* rowp = UC + (size_t)(row0 + ai * 128 + m * 16) * 512 + T * 128 + cl;
                    *(u32x4*)rowp = pack8(acc[ai][0][m][0] * acc[ai][1][m][0], acc[ai][0][m][1] * acc[ai][1][m][1]); }
        }
        return false;
    }
};
struct EpiGate {
    static constexpr bool PERM = true; static constexpr bool BIAS_LDS = false;
    unsigned char* ws;
    __device__ __forceinline__ bool operator()(f32x4 (&acc)[2][2][4][2], const pg8::Unit& u) const {
        EPI_COORDS();
        const int row0 = u.pm * 256 + wr * 64 + fr, col0 = u.pn * 128 + wc * 32 + 8 * fq;
        unsigned char* G8 = ws + WS_G8;
#pragma unroll
        for (int bj = 0; bj < 2; ++bj) {
#pragma unroll
            for (int ai = 0; ai < 2; ++ai)
#pragma unroll
                for (int m = 0; m < 4; ++m) { f32x4 a0 = acc[ai][bj][m][0], a1 = acc[ai][bj][m][1];
#pragma unroll
                    for (int j = 0; j < 4; ++j) { a0[j] = __builtin_amdgcn_fmed3f(a0[j], -160.f, 160.f); a1[j] = __builtin_amdgcn_fmed3f(a1[j], -160.f, 160.f); }
                    v2u w8; w8.x = pk4_fp8(a0[0], a0[1], a0[2], a0[3]); w8.y = pk4_fp8(a1[0], a1[1], a1[2], a1[3]);
                    *(v2u*)(G8 + (size_t)(row0 + ai * 128 + m * 16) * 2048 + col0 + bj * 1024) = w8; }
            __builtin_amdgcn_sched_barrier(0);
        }
        return false;
    }
};
struct EpiMix {
    static constexpr bool PERM = true; static constexpr bool BIAS_LDS = false;
    const unsigned char* G8; bf16* MIX;
    __device__ __forceinline__ bool operator()(f32x4 (&acc)[2][2][4][2], const pg8::Unit& u) const {
        EPI_COORDS();
        const int row0 = u.pm * 256 + wr * 64 + fr, col0 = u.pn * 256 + wc * 32 + 8 * fq;
        const bool first = (u.e == 0);
        constexpr float KE = -0.25f * 1.4426950408889634f;
#define EM_DEC(w, lo4, hi4) do { const f32x2 a_ = __builtin_amdgcn_cvt_pk_f32_fp8((int)(w).x, false), b_ = __builtin_amdgcn_cvt_pk_f32_fp8((int)(w).x, true), \
            c_ = __builtin_amdgcn_cvt_pk_f32_fp8((int)(w).y, false), d_ = __builtin_amdgcn_cvt_pk_f32_fp8((int)(w).y, true); \
            lo4 = (f32x4){a_[0], a_[1], b_[0], b_[1]}; hi4 = (f32x4){c_[0], c_[1], d_[0], d_[1]}; } while (0)
#define EM_EXP(v) do { v = v * KE; _Pragma("unroll") for (int j = 0; j < 4; ++j) v[j] = __builtin_amdgcn_exp2f(v[j]); v = v + 1.0f; } while (0)
#define EM_RCP(v) do { _Pragma("unroll") for (int j = 0; j < 4; ++j) v[j] = __builtin_amdgcn_rcpf(v[j]); } while (0)
#pragma unroll
        for (int ai = 0; ai < 2; ++ai) {
            v2u ga[4][2], gc[4][2];
#pragma unroll
            for (int m = 0; m < 4; ++m)
#pragma unroll
                for (int bj = 0; bj < 2; ++bj) { const unsigned char* gp = G8 + (size_t)(row0 + ai * 128 + m * 16) * 2048 + col0 + bj * 128;
                    if (first) { gc[m][bj] = __builtin_nontemporal_load((const v2u*)gp); ga[m][bj] = *(const v2u*)(gp + 1024); }
                    else ga[m][bj] = __builtin_nontemporal_load((const v2u*)(gp + 1024)); }
            __builtin_amdgcn_sched_barrier(0);
            if (first) {
#pragma unroll
                for (int m = 0; m < 4; ++m)
#pragma unroll
                    for (int bj = 0; bj < 2; ++bj) { f32x4 a0, a1, c0, c1; EM_DEC(ga[m][bj], a0, a1); EM_DEC(gc[m][bj], c0, c1);
                        EM_EXP(a0); EM_EXP(a1); EM_EXP(c0); EM_EXP(c1); EM_RCP(c0); EM_RCP(c1);
                        acc[ai][bj][m][0] *= a0 * c0; acc[ai][bj][m][1] *= a1 * c1; __builtin_amdgcn_sched_barrier(0); }
            } else {
#pragma unroll
                for (int m = 0; m < 4; ++m) { const size_t off = (size_t)(row0 + ai * 128 + m * 16) * 1024 + col0;
#pragma unroll
                    for (int bj = 0; bj < 2; ++bj) { f32x4 a0, a1; EM_DEC(ga[m][bj], a0, a1); EM_EXP(a0); EM_EXP(a1); EM_RCP(a0); EM_RCP(a1);
                        *(u32x4*)(MIX + off + bj * 128) = pack8(acc[ai][bj][m][0] * a0, acc[ai][bj][m][1] * a1); __builtin_amdgcn_sched_barrier(0); } }
            }
            __builtin_amdgcn_sched_barrier(0);
        }
#undef EM_DEC
#undef EM_EXP
#undef EM_RCP
        return first;
    }
};
struct EpiOut {
    static constexpr bool PERM = true; static constexpr bool BIAS_LDS = false;
    const float* X; bf16* O;
    __device__ __forceinline__ bool operator()(f32x4 (&acc)[2][2][4][2], const pg8::Unit& u) const {
        EPI_COORDS();
        const int row0 = u.pm * 256 + wr * 64 + fr, col0 = u.pn * 256 + wc * 32 + 8 * fq;
        f32x4 xa[2][2][2], xb[2][2][2];
#define EO_LOAD(buf, q) do { _Pragma("unroll") for (int mm = 0; mm < 2; ++mm) _Pragma("unroll") for (int bj = 0; bj < 2; ++bj) { \
            const float* xp_ = X + (size_t)(row0 + ((q) >> 1) * 128 + (((q) & 1) * 2 + mm) * 16) * 1024 + col0 + bj * 128; \
            buf[mm][bj][0] = __builtin_nontemporal_load((const f32x4*)xp_); buf[mm][bj][1] = __builtin_nontemporal_load((const f32x4*)(xp_ + 4)); } } while (0)
#define EO_USE(buf, q) do { _Pragma("unroll") for (int mm = 0; mm < 2; ++mm) { const int ai_ = (q) >> 1, m_ = ((q) & 1) * 2 + mm; const size_t off_ = (size_t)(row0 + ai_ * 128 + m_ * 16) * 1024 + col0; \
            _Pragma("unroll") for (int bj = 0; bj < 2; ++bj) *(u32x4*)(O + off_ + bj * 128) = pack8(buf[mm][bj][0] + acc[ai_][bj][m_][0], buf[mm][bj][1] + acc[ai_][bj][m_][1]); } } while (0)
        EO_LOAD(xa, 0); EO_LOAD(xb, 1); __builtin_amdgcn_sched_barrier(0);
        EO_USE(xa, 0); __builtin_amdgcn_sched_barrier(0); EO_LOAD(xa, 2); __builtin_amdgcn_sched_barrier(0);
        EO_USE(xb, 1); __builtin_amdgcn_sched_barrier(0); EO_LOAD(xb, 3); __builtin_amdgcn_sched_barrier(0);
        EO_USE(xa, 2); __builtin_amdgcn_sched_barrier(0);
        EO_USE(xb, 3); __builtin_amdgcn_sched_barrier(0);
#undef EO_LOAD
#undef EO_USE
        return false;
    }
};
struct EpiSwiglu {
    static constexpr bool PERM = true; static constexpr bool BIAS_LDS = true;
    const float* bgu; unsigned char* ACT; const LAS unsigned char* gaux; LAS unsigned char* baux;
    __device__ __forceinline__ void bias_dma(const pg8::Unit& u, int par, int tid, int wid) const {
        const int i = tid & 255;
        const float* src = bgu + (size_t)u.e * 2048 + u.pn * 128 + (i < 128 ? i : 1024 + (i - 128));
        __builtin_amdgcn_global_load_lds((const unsigned*)src, (LAS unsigned*)(baux + par * 1024 + (wid & 3) * 256), 4, 0, 0);
    }
    __device__ __forceinline__ bool operator()(f32x4 (&acc)[2][2][4][2], const pg8::Unit& u) const {
        EPI_COORDS();
        const int row0 = u.pm * 256 + wr * 64 + fr, ch0 = u.pn * 128 + wc * 32 + 8 * fq;
        float rs[2][4];
#pragma unroll
        for (int ai = 0; ai < 2; ++ai)
#pragma unroll
            for (int m = 0; m < 4; ++m) { const int r = ai * 128 + wr * 64 + m * 16 + fr; rs[ai][m] = ((const LAS float*)(gaux + u.lrows))[2 * (r < u.nvalid ? r : 0) + 1]; }
        const LAS float* bp = (const LAS float*)(baux + (u.lrows >> 1)) + wc * 32 + 8 * fq;
        f32x4 bg[2], bl1[2];
#pragma unroll
        for (int n = 0; n < 2; ++n) { bg[n] = *(const LAS f32x4*)(bp + 4 * n); bl1[n] = *(const LAS f32x4*)(bp + 128 + 4 * n) + 1.0f; }
        constexpr float CE = -1.702f * 1.4426950408889634f;
#pragma unroll
        for (int ai = 0; ai < 2; ++ai)
#pragma unroll
            for (int m = 0; m < 4; ++m) { f32x4 av[2]; const float r1 = rs[ai][m];
#pragma unroll
                for (int n = 0; n < 2; ++n) { f32x4 g = acc[ai][0][m][n] * r1 + bg[n], l = acc[ai][1][m][n] * r1 + bl1[n];
#pragma unroll
                    for (int j = 0; j < 4; ++j) { g[j] = fminf(g[j], 7.0f); l[j] = __builtin_amdgcn_fmed3f(l[j], -6.0f, 8.0f); }
                    f32x4 t = g * CE;
#pragma unroll
                    for (int j = 0; j < 4; ++j) t[j] = __builtin_amdgcn_exp2f(t[j]);
                    t = t * 0.25f + 0.25f;
#pragma unroll
                    for (int j = 0; j < 4; ++j) t[j] = __builtin_amdgcn_rcpf(t[j]);
                    av[n] = (g * t) * l; }
                v2u w8; w8.x = pk4_fp8(av[0][0], av[0][1], av[0][2], av[0][3]); w8.y = pk4_fp8(av[1][0], av[1][1], av[1][2], av[1][3]);
                *(v2u*)(ACT + (size_t)(row0 + ai * 128 + m * 16) * 1024 + ch0) = w8; }
        return false;
    }
};
struct EpiDown {
    static constexpr bool PERM = true; static constexpr bool BIAS_LDS = true;
    const float* bd; unsigned char* Y; LAS unsigned char* baux;
    __device__ __forceinline__ void bias_dma(const pg8::Unit& u, int par, int tid, int wid) const {
        __builtin_amdgcn_global_load_lds((const unsigned*)(bd + (size_t)u.e * 1024 + u.pn * 256 + (tid & 255)), (LAS unsigned*)(baux + par * 1024 + (wid & 3) * 256), 4, 0, 0);
    }
    __device__ __forceinline__ bool operator()(f32x4 (&acc)[2][2][4][2], const pg8::Unit& u) const {
        EPI_COORDS();
        const int row0 = u.pm * 256 + wr * 64 + fr, col0 = u.pn * 256 + wc * 32 + 8 * fq;
        const LAS float* bp = (const LAS float*)(baux + (u.lrows >> 1)) + wc * 32 + 8 * fq;
#pragma unroll
        for (int bj = 0; bj < 2; ++bj) {
            const f32x4 b0 = *(const LAS f32x4*)(bp + bj * 128) * 16.f, b1 = *(const LAS f32x4*)(bp + bj * 128 + 4) * 16.f;
#pragma unroll
            for (int ai = 0; ai < 2; ++ai)
#pragma unroll
                for (int m = 0; m < 4; ++m) { const f32x4 a0 = acc[ai][bj][m][0] + b0, a1 = acc[ai][bj][m][1] + b1;
                    v2u w8; w8.x = pk4_fp8(a0[0], a0[1], a0[2], a0[3]); w8.y = pk4_fp8(a1[0], a1[1], a1[2], a1[3]);
                    *(v2u*)(Y + (size_t)(row0 + ai * 128 + m * 16) * 1024 + col0 + bj * 128) = w8; }
            __builtin_amdgcn_sched_barrier(0);
        }
        return false;
    }
};

__device__ __forceinline__ void p0_transpose_item(const float* W, int ldw, int k0, int n0s, bf16* WT, size_t drow0, int ldk, int kd0, LAS float* scr, int lane) {
    float wv[32];
#pragma unroll
    for (int i = 0; i < 32; ++i) wv[i] = W[(size_t)(k0 + 2 * i + (lane >> 5)) * ldw + n0s + (lane & 31)];
    __builtin_amdgcn_sched_barrier(0);
#pragma unroll
    for (int i = 0; i < 32; ++i) scr[(2 * i + (lane >> 5)) * 33 + (lane & 31)] = wv[i];
    LDS_WAIT(); asm volatile("" ::: "memory");
    const int c = lane & 7;
#pragma unroll
    for (int j = 0; j < 4; ++j) { const int n = (lane >> 3) + 8 * j; const LAS float* s = scr + (8 * c) * 33 + n;
        v4u o; o.x = pk2(s[0 * 33], s[1 * 33]); o.y = pk2(s[2 * 33], s[3 * 33]); o.z = pk2(s[4 * 33], s[5 * 33]); o.w = pk2(s[6 * 33], s[7 * 33]);
        *(GAS v4u*)(WT + (drow0 + n) * (size_t)ldk + kd0 + 8 * c) = o; }
    LDS_WAIT(); asm volatile("" ::: "memory");
}
__device__ __forceinline__ void p0_item8_load(f32x4 (&v)[4][4], const float* W, int ldw, int k0, int n0s, int lane) {
    const int ng = lane & 7, kg0 = lane >> 3;
#pragma unroll
    for (int b = 0; b < 4; ++b)
#pragma unroll
        for (int r = 0; r < 4; ++r) v[b][r] = __builtin_nontemporal_load((const GAS f32x4*)(W + (size_t)(k0 + 4 * (kg0 + 8 * b) + r) * ldw + n0s + 4 * ng));
}
__device__ __forceinline__ void p0_item8_finish(const f32x4 (&v)[4][4], int k0, unsigned char* WT, size_t drow0, int ldk, int kd0, float scale, const float* kscale, LAS float* scrf, int lane) {
    LAS unsigned char* scr = (LAS unsigned char*)scrf;
    const int ng = lane & 7, kg0 = lane >> 3;
#pragma unroll
    for (int b = 0; b < 4; ++b) { const int kk = 4 * (kg0 + 8 * b);
        float ks[4];
#pragma unroll
        for (int r = 0; r < 4; ++r) ks[r] = kscale ? scale * kscale[k0 + kk + r] : scale;
#pragma unroll
        for (int c = 0; c < 4; ++c) *(LAS unsigned*)(scr + (4 * ng + c) * 144 + kk) = pk4_fp8(v[b][0][c] * ks[0], v[b][1][c] * ks[1], v[b][2][c] * ks[2], v[b][3][c] * ks[3]); }
    LDS_WAIT(); asm volatile("" ::: "memory");
    const int ch = lane & 7;
#pragma unroll
    for (int j = 0; j < 4; ++j) { const int n = (lane >> 3) + 8 * j; const v4u o = *(const LAS v4u*)(scr + n * 144 + 16 * ch);
        *(GAS v4u*)(WT + (drow0 + n) * (size_t)ldk + kd0 + 16 * ch) = o; }
    LDS_WAIT(); asm volatile("" ::: "memory");
}
__device__ __forceinline__ void p0_transpose_item8(const float* W, int ldw, int k0, int n0s, unsigned char* WT, size_t drow0, int ldk, int kd0, float scale, const float* kscale, LAS float* scrf, int lane) {
    f32x4 v[4][4]; p0_item8_load(v, W, ldw, k0, n0s, lane); p0_item8_finish(v, k0, WT, drow0, ldk, kd0, scale, kscale, scrf, lane);
}
__device__ __forceinline__ int win_src_col(int vb) {
    const int v = vb * 32;
    if (v < 512) return v;
    if (v < 1536) { const int T = (v - 512) >> 8, j = (v - 512) & 255; return j < 128 ? 512 + 128 * T + j : 1024 + 128 * T + (j - 128); }
    if (v < 3072) return v;
    { const int T = (v - 3072) >> 8, j = (v - 3072) & 255; return j < 128 ? 3080 + 128 * T + j : 4104 + 128 * T + (j - 128); }
}
__device__ __forceinline__ int wgu_src_col(int vb) { const int T = vb >> 3, j = (vb & 7) * 32; return j < 128 ? 128 * T + j : 1024 + 128 * T + (j - 128); }

struct ConvItem { const float* W; unsigned char* WT; const float* ks; int ldw, k0, n0s; size_t drow0; };
__device__ __forceinline__ ConvItem conv_item(const Args& a, int r) {
    unsigned char* ws = a.ws; ConvItem c; constexpr int I_GU = 32 * 8 * 64;
    if (r < I_GU) { const int e = r / 512, q = r % 512, kb = q / 64, vb = q % 64; c.W = a.w_gate_up + (size_t)e * 1024 * 2048; c.ldw = 2048; c.k0 = 128 * kb; c.n0s = wgu_src_col(vb); c.WT = ws + WS_WGU; c.drow0 = (size_t)e * 2048 + vb * 32; c.ks = a.g_ffn; }
    else { r -= I_GU; const int e = r / 256, q = r % 256, kb = q / 32, nb = q % 32; c.W = a.w_down + (size_t)e * 1024 * 1024; c.ldw = 1024; c.k0 = 128 * kb; c.n0s = 32 * nb; c.WT = ws + WS_WD; c.drow0 = (size_t)e * 1024 + nb * 32; c.ks = nullptr; }
    return c;
}
__device__ __forceinline__ void cvt_chunk(const Frame& F, const Args& a, int chunk) {
    LAS float* scr = (LAS float*)(F.lds + RING_OFF + F.wave * 16384);
    const ConvItem c = conv_item(a, chunk * 8 + F.wave);
    p0_transpose_item8(c.W, c.ldw, c.k0, c.n0s, c.WT, c.drow0, 1024, c.k0, 64.f, c.ks, scr, F.lane);
}
__device__ __forceinline__ void cvt_drain(const Frame& F, const Args& a, int upto) {
    volatile LAS unsigned* st = (volatile LAS unsigned*)(F.lds + MISC_OFF) + 8;
    unsigned* cnt = (unsigned*)(a.ws + WS_CTL) + CW_CVT;
    __syncthreads();
    for (unsigned p = 0;; p ^= 1u) {
        if (F.tid == 0) st[6 + p] = xb_add(cnt, 1u);
        __syncthreads();
        const unsigned ch = st[6 + p];
        if (ch < (unsigned)CVT_NCH) cvt_chunk(F, a, (int)ch);
        if (ch >= (unsigned)upto) break;
    }
    __syncthreads();
}
__device__ __forceinline__ void xcd_barrier_fill(const XcdBarrier& b, const Frame& F, const Args& a, const bool want_local = false) {
    asm volatile("s_waitcnt vmcnt(0)" ::: "memory");
    __syncthreads();
    volatile LAS unsigned* st = b.st;
    unsigned* bar = b.bar;
    if (F.tid == 0) {
        __builtin_amdgcn_s_waitcnt(0);
        unsigned nloc = st[0], nx = st[1];
        if (nloc == 0u) { xcd_barrier_complete(bar, b.x, nloc, nx); st[0] = nloc; st[1] = nx; }
        const bool local = want_local && (nx & 0x10000u) != 0u;
        nx &= 0xffffu;
        const unsigned old = xb_add(&bar[XB_XSUB(b.x)], 1u);
        const unsigned gen = old / nloc;
        if (old + 1u == (gen + 1u) * nloc) {
            if (!local) {
            __builtin_amdgcn_fence(__ATOMIC_RELEASE, "agent");
            asm volatile("s_waitcnt vmcnt(0)" ::: "memory");
            const unsigned og = xb_add(&bar[XB_TOP], 1u);
            const unsigned tg = og / nx;
            if (og + 1u == (tg + 1u) * nx) xb_add(&bar[XB_TOPGEN], 1u);
            else XB_SPIN(xb_ld(&bar[XB_TOPGEN]) == tg, bar);
            }
            xb_add(&bar[XB_XGEN(b.x)], 1u);
            __builtin_amdgcn_fence(__ATOMIC_ACQUIRE, "agent");
            asm volatile("s_waitcnt vmcnt(0)" ::: "memory");
            st[2] = 0xffffffffu;
        } else st[2] = gen;
    }
    __syncthreads();
    const unsigned gen = st[2];
    if (gen != 0xffffffffu) {
        unsigned* cnt = (unsigned*)(a.ws + WS_CTL) + CW_CVT;
        unsigned sp = 0u, exh = 0u;
        const unsigned nloc = st[0];
        for (unsigned p = 0;; p ^= 2u) {
            if (F.tid == 0) {
                const unsigned arr = xb_ld(&bar[XB_XSUB(b.x)]) - gen * nloc;
                unsigned done = (xb_ld(&bar[XB_XGEN(b.x)]) != gen) ? 1u : 0u, ch = 0xffffffffu;
                if (!done) {
                    if (!exh && arr + CVT_STOP < nloc) { ch = xb_add(cnt, 1u); if (ch >= (unsigned)CVT_NCH) { ch = 0xffffffffu; exh = 1u; } }
                    if (ch == 0xffffffffu) { __builtin_amdgcn_s_sleep(1);
                        if ((++sp & 255u) == 0u) { if (xb_ld(&bar[XB_TMO])) done = 1u; else if (sp > XB_SPIN_CAP) { atomicAdd(&bar[XB_TMO], 1u); done = 1u; } } }
                }
                st[3 + p] = done; st[4 + p] = ch;
            }
            __syncthreads();
            const unsigned done = st[3 + p], ch = st[4 + p];
            if (done) break;
            if (ch != 0xffffffffu) cvt_chunk(F, a, (int)ch);
        }
        if (F.tid == 0) { __builtin_amdgcn_fence(__ATOMIC_ACQUIRE, "agent"); asm volatile("s_waitcnt vmcnt(0)" ::: "memory"); }
    }
    __syncthreads();
}
__device__ __forceinline__ void p0_prologue(const Frame& F, const Args& a) {
    unsigned char* ws = a.ws;
    bf16* Win_t = (bf16*)(ws + WS_WIN); bf16* W3_t = (bf16*)(ws + WS_W3); bf16* Wout_t = (bf16*)(ws + WS_WOUT);
    LAS float* scr = (LAS float*)(F.lds + RING_OFF + F.wave * 16384);
    const int gw = F.vcu * 8 + F.wave, NGW = F.G * 8;
    constexpr int I_IN = 16 * 96  , I_G8 = 8 * 64  , I_CO = 8 * 32, I_AO = 8 * 32, I_OUT = 16 * 32;
    constexpr int NITEMS = I_G8 + I_IN + I_CO + I_AO + I_OUT;
    for (int it = gw; it < NITEMS; it += NGW) {
        int r = it;
        if (r < I_G8) { const int kb = r / 64, vb = 96 + r % 64;
            p0_transpose_item8(a.w_in, INCOLS, 128 * kb, win_src_col(vb), ws + WS_WG8, (size_t)(vb - 96) * 32, 1024, 128 * kb, 64.f, nullptr, scr, F.lane); continue; } r -= I_G8;
        if (r < I_IN) { const int kb = r / 96, vb = r % 96; p0_transpose_item(a.w_in, INCOLS, 64 * kb, win_src_col(vb), Win_t, (size_t)vb * 32, 1024, 64 * kb, scr, F.lane); continue; } r -= I_IN;
        if (r < I_CO) { const int kb = r / 32, nb = r % 32; p0_transpose_item(a.w_conv_o, 1024, 64 * kb, 32 * nb, W3_t, (size_t)nb * 32, 1024, 64 * kb, scr, F.lane); continue; } r -= I_CO;
        if (r < I_AO) { const int kb = r / 32, nb = r % 32; p0_transpose_item(a.w_attn_o, 1024, 64 * kb, 32 * nb, W3_t, (size_t)nb * 32, 1024, 512 + 64 * kb, scr, F.lane); continue; } r -= I_AO;
        { const int kb = r / 32, nb = r % 32; p0_transpose_item(a.w_out, 1024, 64 * kb, 32 * nb, Wout_t, (size_t)nb * 32, 1024, 64 * kb, scr, F.lane); }
    }
    __syncthreads();
    LAS float* wf = (LAS float*)(F.lds + RING_OFF);
    { float fv[16];
#pragma unroll
      for (int j = 0; j < 16; ++j) { const int i = F.tid + 512 * j; fv[j] = a.w_in[(size_t)(i >> 3) * INCOLS + 3072 + (i & 7)]; }
      __builtin_amdgcn_sched_barrier(0);
#pragma unroll
      for (int j = 0; j < 16; ++j) { const int i = F.tid + 512 * j; wf[(i & 7) * 1024 + (i >> 3)] = fv[j]; } }
    __syncthreads();
    bf16* Hb = (bf16*)(ws + WS_H); float* LOGF = (float*)(ws + WS_LOGF);
    f32x4 gv[4];
#pragma unroll
    for (int j = 0; j < 4; ++j) gv[j] = ((const GAS f32x4*)a.g_mix)[F.lane + 64 * j];
    const float bfl = a.b_f[F.lane & 7];
    f32x4 xn[2][4];
#pragma unroll
    for (int q = 0; q < 2; ++q) { const int mq = gw + q * NGW; const GAS f32x4* xr = (const GAS f32x4*)(a.x + (size_t)(mq < NTOK ? mq : gw) * 1024) + F.lane;
#pragma unroll
        for (int j = 0; j < 4; ++j) xn[q][j] = __builtin_nontemporal_load(xr + 64 * j); }
    int par = 0;
    for (int m = gw; m < NTOK; m += NGW, par ^= 1) {
        f32x4 v[4]; float s = 0.f;
        { const int mq = m + 2 * NGW; const GAS f32x4* xr = (const GAS f32x4*)(a.x + (size_t)(mq < NTOK ? mq : gw) * 1024) + F.lane;
          if (par == 0) {
#pragma unroll
            for (int j = 0; j < 4; ++j) { v[j] = xn[0][j]; xn[0][j] = __builtin_nontemporal_load(xr + 64 * j); } }
          else {
#pragma unroll
            for (int j = 0; j < 4; ++j) { v[j] = xn[1][j]; xn[1][j] = __builtin_nontemporal_load(xr + 64 * j); } } }
#pragma unroll
        for (int j = 0; j < 4; ++j) s += (v[j].x * v[j].x + v[j].y * v[j].y) + (v[j].z * v[j].z + v[j].w * v[j].w);
        const float rstd = 1.f / sqrtf(wave_sum(s) * (1.f / 1024.f) + RMS_EPS);
#pragma unroll
        for (int j = 0; j < 4; ++j) v[j] = (v[j] * rstd) * gv[j];
        GAS unsigned long long* o8 = (GAS unsigned long long*)(Hb + (size_t)m * 1024) + F.lane;
#pragma unroll
        for (int j = 0; j < 4; ++j) o8[64 * j] = (unsigned long long)pk2(v[j].x, v[j].y) | ((unsigned long long)pk2(v[j].z, v[j].w) << 32);
        GAS unsigned* o4 = (GAS unsigned*)(ws + WS_H8 + (size_t)m * 1024) + F.lane;
#pragma unroll
        for (int j = 0; j < 4; ++j) o4[64 * j] = pk4_fp8(v[j].x * 16.f, v[j].y * 16.f, v[j].z * 16.f, v[j].w * 16.f);
        float p[8];
#pragma unroll
        for (int c = 0; c < 8; ++c) { float d = 0.f;
#pragma unroll
            for (int j = 0; j < 4; ++j) { const f32x4 w = ((const LAS f32x4*)(wf + c * 1024))[F.lane + 64 * j]; d += (v[j].x * w.x + v[j].y * w.y) + (v[j].z * w.z + v[j].w * w.w); }
            p[c] = d; }
#pragma unroll
        for (int c = 0; c < 4; ++c) { const bool up = (F.lane & 4) != 0; const float send = up ? p[c] : p[c + 4], keep = up ? p[c + 4] : p[c]; p[c] = keep + __shfl_xor(send, 4); }
#pragma unroll
        for (int c = 0; c < 2; ++c) { const bool up = (F.lane & 2) != 0; const float send = up ? p[c] : p[c + 2], keep = up ? p[c + 2] : p[c]; p[c] = keep + __shfl_xor(send, 2); }
        { const bool up = (F.lane & 1) != 0; const float send = up ? p[0] : p[1], keep = up ? p[1] : p[0]; p[0] = keep + __shfl_xor(send, 1); }
        float tot = p[0]; tot += __shfl_xor(tot, 8); tot += __shfl_xor(tot, 16); tot += __shfl_xor(tot, 32);
        if (F.lane < 8) { const float z = tot + bfl; LOGF[(size_t)m * 8 + F.lane] = fminf(z, 0.f) - log1pf(expf(-fabsf(z))); }
    }
}

__device__ __forceinline__ void p2_conv(const Frame& F, const Args& a) {
    unsigned char* ws = a.ws;
    const bf16* CB = (const bf16*)(ws + WS_CB); const bf16* UC = (const bf16*)(ws + WS_UC); bf16* A3 = (bf16*)(ws + WS_H);
    const int ch = F.lane * 8;
    float w0[8], w1[8], w2[8];
#pragma unroll
    for (int j = 0; j < 8; ++j) { w0[j] = a.conv_w[ch + j]; w1[j] = a.conv_w[512 + ch + j]; w2[j] = a.conv_w[1024 + ch + j]; }
    for (int panel = F.vcu; panel < NTOK / 256; panel += F.G) {
        const int r0 = panel * 256 + F.wave * 32;
        const GAS v4u* up = (const GAS v4u*)(UC + (size_t)r0 * 512 + ch); const GAS v4u* cp = (const GAS v4u*)(CB + (size_t)r0 * 512 + ch);
        v4u um2 = (v4u){0u, 0u, 0u, 0u}, um1 = um2;
        if ((r0 & (SEQLEN - 1)) != 0) { um2 = up[-128]; um1 = up[-64]; }
        v4u ub[2][8], cb[2][8];
#pragma unroll
        for (int j = 0; j < 8; ++j) { ub[0][j] = __builtin_nontemporal_load(up + 64 * j); cb[0][j] = __builtin_nontemporal_load(cp + 64 * j); }
#pragma unroll
        for (int b = 0; b < 4; ++b) {
            if (b < 3) {
#pragma unroll
                for (int j = 0; j < 8; ++j) { ub[(b + 1) & 1][j] = __builtin_nontemporal_load(up + 64 * (8 * (b + 1) + j)); cb[(b + 1) & 1][j] = __builtin_nontemporal_load(cp + 64 * (8 * (b + 1) + j)); }
            }
            __builtin_amdgcn_sched_barrier(0);
#pragma unroll
            for (int j = 0; j < 8; ++j) {
                const v4u u2 = ub[b & 1][j], c4 = cb[b & 1][j];
                const unsigned U0[4] = {um2.x, um2.y, um2.z, um2.w}, U1[4] = {um1.x, um1.y, um1.z, um1.w}, U2[4] = {u2.x, u2.y, u2.z, u2.w}, B[4] = {c4.x, c4.y, c4.z, c4.w};
                unsigned o[4];
#pragma unroll
                for (int q = 0; q < 4; ++q) {
                    const float lo = bf_lo(B[q]) * (w0[2 * q] * bf_lo(U0[q]) + w1[2 * q] * bf_lo(U1[q]) + w2[2 * q] * bf_lo(U2[q]));
                    const float hi = bf_hi(B[q]) * (w0[2 * q + 1] * bf_hi(U0[q]) + w1[2 * q + 1] * bf_hi(U1[q]) + w2[2 * q + 1] * bf_hi(U2[q]));
                    o[q] = pk2(lo, hi); }
                *(GAS v4u*)(A3 + (size_t)(r0 + 8 * b + j) * 1024 + ch) = (v4u){o[0], o[1], o[2], o[3]};
                um2 = um1; um1 = u2;
            }
            __builtin_amdgcn_sched_barrier(0);
        }
    }
}
__device__ __forceinline__ void p2_keybias(const Frame& F, const float* LOGF, int bh, LAS float* kb, LAS float* red) {
    const int b = bh >> 3, h = bh & 7;
    int tid = threadIdx.x; asm volatile("" : "+v"(tid));
    const int lane = tid & 63;
    const float* src = LOGF + ((size_t)b * SEQLEN) * 8 + h + (size_t)tid * 32;
    float v[4]; float s = 0.f;
#pragma unroll
    for (int j = 0; j < 4; ++j) { v[j] = src[j * 8]; s += v[j]; v[j] = s; }
    float ws_ = s;
#pragma unroll
    for (int o = 1; o < 64; o <<= 1) { const float t = __shfl_up(ws_, o); if (lane >= o) ws_ += t; }
    if (lane == 63) red[tid >> 6] = ws_;
    __syncthreads();
    float woff = 0.f;
    for (int w = 0; w < (tid >> 6); ++w) woff += red[w];
    const float base = woff + ws_ - s;
#pragma unroll
    for (int j = 0; j < 4; ++j) kb[tid * 4 + j] = -(base + v[j]) * 1.4426950408889634f;
    __syncthreads();
}

__device__ __forceinline__ unsigned bf16_rne_bits(float f) { unsigned u = __builtin_bit_cast(unsigned, f); return (u + 0x7fffu + ((u >> 16) & 1u)) & 0xffff0000u; }
__device__ __forceinline__ void p5_router(const Frame& F, const Args& a) {
    typedef short bf16x8 __attribute__((ext_vector_type(8)));
    unsigned char* ws = a.ws;
    const bf16* X1 = (const bf16*)(ws + WS_X1B); unsigned char* H2 = ws + WS_H2;
    unsigned* CNT = (unsigned*)(ws + WS_CTL) + CW_CNT; v2u* LIST = (v2u*)(ws + WS_LIST); unsigned* TOKSLOT = (unsigned*)(ws + WS_TOKSLOT); float* TOKW = (float*)(ws + WS_TOKW);
    LAS v4u* whi = (LAS v4u*)(F.lds + RING_OFF); LAS v4u* wlo = whi + 4096;
    for (int idx = F.tid; idx < 4096; idx += 512) { const int sidx = idx >> 7, eb = (idx >> 6) & 1, ln = idx & 63, c = ln & 15, q = ln >> 4;
        unsigned hb[8], lb[8];
#pragma unroll
        for (int j = 0; j < 8; ++j) { const int k = 32 * sidx + 8 * q + j; const float w = a.w_router[k * 32 + 16 * eb + c] * a.g_ffn[k];
            hb[j] = bf16_rne_bits(w); lb[j] = bf16_rne_bits(w - __uint_as_float(hb[j])); }
        whi[idx] = (v4u){(hb[0] >> 16) | hb[1], (hb[2] >> 16) | hb[3], (hb[4] >> 16) | hb[5], (hb[6] >> 16) | hb[7]};
        wlo[idx] = (v4u){(lb[0] >> 16) | lb[1], (lb[2] >> 16) | lb[3], (lb[4] >> 16) | lb[5], (lb[6] >> 16) | lb[7]}; }
    LAS int* hist = (LAS int*)(F.lds + P5_OFF); LAS int* basev = hist + 32; LAS unsigned* ent = (LAS unsigned*)(hist + 64);
    LAS float* rstd_l = (LAS float*)(F.lds + GAUX_OFF);
    const int fr = F.lane & 15, fq = F.lane >> 4;
    const float br0 = a.b_router[fr], br1 = a.b_router[16 + fr];
    __syncthreads();
    for (int chunk = F.vcu; chunk < NTOK / 256; chunk += F.G) {
        if (F.tid < 32) hist[F.tid] = 0;
        __syncthreads();
#pragma unroll 1
        for (int pass = 0; pass < 2; ++pass) {
            const int rl0 = pass * 128 + F.wave * 16;
            const bf16* xp = X1 + (size_t)(chunk * 256 + rl0 + fr) * 1024 + 8 * fq;
            unsigned char* hp = H2 + (size_t)(chunk * 256 + rl0 + fr) * 1024 + 8 * fq;
            f32x4 acc0 = (f32x4){0.f, 0.f, 0.f, 0.f}, acc1 = acc0; float ss = 0.f;
            v4u buf[8];
#pragma unroll
            for (int p = 0; p < 8; ++p) buf[p] = *(const GAS v4u*)(xp + 32 * p);
#pragma unroll 1
            for (int s0 = 0; s0 < 32; s0 += 8) {
#pragma unroll
                for (int p = 0; p < 8; ++p) { const int sidx = s0 + p;
                    const v4u xv = buf[p];
                    if (s0 + 8 < 32) buf[p] = *(const GAS v4u*)(xp + 32 * (sidx + 8));
                    const float xs[8] = {bf_lo(xv.x), bf_hi(xv.x), bf_lo(xv.y), bf_hi(xv.y), bf_lo(xv.z), bf_hi(xv.z), bf_lo(xv.w), bf_hi(xv.w)};
#pragma unroll
                    for (int j = 0; j < 8; ++j) ss += xs[j] * xs[j];
                    v2u h8; h8.x = pk4_fp8(xs[0] * 16.f, xs[1] * 16.f, xs[2] * 16.f, xs[3] * 16.f); h8.y = pk4_fp8(xs[4] * 16.f, xs[5] * 16.f, xs[6] * 16.f, xs[7] * 16.f);
                    *(GAS v2u*)(hp + 32 * sidx) = h8;
                    const bf16x8 ah = __builtin_bit_cast(bf16x8, xv);
                    const bf16x8 wh0 = __builtin_bit_cast(bf16x8, whi[(sidx * 2 + 0) * 64 + F.lane]), wh1 = __builtin_bit_cast(bf16x8, whi[(sidx * 2 + 1) * 64 + F.lane]);
                    const bf16x8 wl0 = __builtin_bit_cast(bf16x8, wlo[(sidx * 2 + 0) * 64 + F.lane]), wl1 = __builtin_bit_cast(bf16x8, wlo[(sidx * 2 + 1) * 64 + F.lane]);
                    acc0 = __builtin_amdgcn_mfma_f32_16x16x32_bf16(ah, wh0, acc0, 0, 0, 0); acc1 = __builtin_amdgcn_mfma_f32_16x16x32_bf16(ah, wh1, acc1, 0, 0, 0);
                    acc0 = __builtin_amdgcn_mfma_f32_16x16x32_bf16(ah, wl0, acc0, 0, 0, 0); acc1 = __builtin_amdgcn_mfma_f32_16x16x32_bf16(ah, wl1, acc1, 0, 0, 0); }
            }
            ss += __shfl_xor(ss, 16); ss += __shfl_xor(ss, 32);
            const float rstd = 1.f / sqrtf(ss * (1.f / 1024.f) + RMS_EPS);
            if (fq == 0) rstd_l[rl0 + fr] = rstd;
#pragma unroll
            for (int reg = 0; reg < 4; ++reg) {
                const float rsr = __shfl(rstd, 4 * fq + reg);
                float l0 = acc0[reg] * rsr + br0, l1 = acc1[reg] * rsr + br1;
                float tv[4]; int ti[4];
#pragma unroll
                for (int k = 0; k < 4; ++k) { float bv; int bi; if (l1 > l0) { bv = l1; bi = 16 + fr; } else { bv = l0; bi = fr; }
#pragma unroll
                    for (int o = 1; o < 16; o <<= 1) { const float ov = __shfl_xor(bv, o); const int oi = __shfl_xor(bi, o); if (ov > bv || (ov == bv && oi < bi)) { bv = ov; bi = oi; } }
                    tv[k] = bv; ti[k] = bi; if (bi == fr) l0 = -INFINITY; if (bi == 16 + fr) l1 = -INFINITY; }
                const float e1 = expf(tv[1] - tv[0]), e2 = expf(tv[2] - tv[0]), e3 = expf(tv[3] - tv[0]);
                const float inv = 1.f / (1.f + e1 + e2 + e3);
                if (fr < 4) { const int ek = fr == 0 ? ti[0] : (fr == 1 ? ti[1] : (fr == 2 ? ti[2] : ti[3]));
                    const float gk = (fr == 0 ? 1.f : (fr == 1 ? e1 : (fr == 2 ? e2 : e3))) * inv;
                    const int rl = rl0 + 4 * fq + reg;
                    const int pos = __hip_atomic_fetch_add(&hist[ek], 1, __ATOMIC_RELAXED, __HIP_MEMORY_SCOPE_WORKGROUP);
                    ent[rl * 4 + fr] = ((unsigned)ek << 16) | (unsigned)pos; TOKW[(size_t)(chunk * 256 + rl) * 4 + fr] = gk; }
            }
        }
        __syncthreads();
        if (F.tid < 32) { const int n = hist[F.tid]; basev[F.tid] = n ? (int)__hip_atomic_fetch_add(CNT + F.tid, (unsigned)n, RLX_AGENT) : 0; }
        __syncthreads();
        for (int i = F.tid; i < 1024; i += 512) { const unsigned en = ent[i]; const int e = (int)(en >> 16), pos = basev[e] + (int)(en & 0xffffu); const int rl = i >> 2, row = chunk * 256 + rl;
            LIST[(size_t)e * LISTCAP + pos] = (v2u){(unsigned)row, __float_as_uint(rstd_l[rl])}; TOKSLOT[(size_t)row * 4 + (i & 3)] = ((unsigned)e << 16) | (unsigned)pos; }
        __syncthreads();
    }
}
__device__ __forceinline__ void moe_table(const Frame& F, const Args& a, int nct) {
    LAS int* tab = (LAS int*)(F.lds + MOETAB_OFF);
    unsigned* CNT = (unsigned*)(a.ws + WS_CTL) + CW_CNT;
    __syncthreads();
    if (F.tid < 64) {
        const int e = F.lane;
        const int c = (e < 32) ? (int)__hip_atomic_load(CNT + (e & 31), RLX_AGENT) : 0;
        const int ntl = (c + 255) >> 8;
        int ps = ntl;
#pragma unroll
        for (int o = 1; o < 32; o <<= 1) { const int t = __shfl_up(ps, o); if (e >= o) ps += t; }
        const int pt = ps - ntl;
        if (e < 32) { tab[e] = pt * nct; tab[64 + e] = ntl; tab[96 + e] = pt; tab[128 + e] = c; }
        if (e == 31) tab[32] = ps * nct;
    }
    __syncthreads();
}
#define P8_SLOTS(S, W, mm) do { const int mc_ = (mm) < NTOK ? (mm) : gw; S = TOKSLOT[mc_]; W = TOKW[mc_]; } while (0)
#define P8_ISSUE(V, Y, S, mm) do { const int mc_ = (mm) < NTOK ? (mm) : gw; const GAS v2u* xr_ = (const GAS v2u*)(X1B + (size_t)mc_ * 1024) + F.lane; \
    _Pragma("unroll") for (int j = 0; j < 4; ++j) { const v2u xb_ = __builtin_nontemporal_load(xr_ + 64 * j); V[j] = (f32x4){bf_lo(xb_.x), bf_hi(xb_.x), bf_lo(xb_.y), bf_hi(xb_.y)}; } \
    const unsigned tsv_[4] = {S.x, S.y, S.z, S.w}; \
    _Pragma("unroll") for (int k = 0; k < 4; ++k) { const int e_ = (int)(tsv_[k] >> 16) & 31, pos_ = (int)(tsv_[k] & 0xffffu); const size_t slot_ = (size_t)tab[96 + e_] * 256 + pos_; \
        const GAS unsigned* yr_ = (const GAS unsigned*)(Y_ + slot_ * 1024) + F.lane; \
        _Pragma("unroll") for (int j = 0; j < 4; ++j) Y[k][j] = __builtin_nontemporal_load(yr_ + 64 * j); } } while (0)
#define P8_FINISH(V, Y, W, mm) do { const float w_[4] = {W.x, W.y, W.z, W.w}; \
    _Pragma("unroll") for (int k = 0; k < 4; ++k) _Pragma("unroll") for (int j = 0; j < 4; ++j) { const f32x2 lo_ = __builtin_amdgcn_cvt_pk_f32_fp8((int)Y[k][j], false), hi_ = __builtin_amdgcn_cvt_pk_f32_fp8((int)Y[k][j], true); \
        V[j] += (f32x4){lo_.x, lo_.y, hi_.x, hi_.y} * (w_[k] * 0.0625f); } \
    float s_ = 0.f; _Pragma("unroll") for (int j = 0; j < 4; ++j) s_ += (V[j].x * V[j].x + V[j].y * V[j].y) + (V[j].z * V[j].z + V[j].w * V[j].w); \
    const float rstd_ = 1.f / sqrtf(wave_sum(s_) * (1.f / 1024.f) + RMS_EPS); \
    if ((mm) < NTOK) { GAS f32x4* xo_ = (GAS f32x4*)(OUT + (size_t)(mm) * 1024) + F.lane; _Pragma("unroll") for (int j = 0; j < 4; ++j) __builtin_nontemporal_store((V[j] * rstd_) * gv[j], xo_ + 64 * j); } } while (0)
__device__ __forceinline__ void p8_combine(const Frame& F, const Args& a) {
    unsigned char* ws = a.ws;
    const LAS int* tab = (const LAS int*)(F.lds + MOETAB_OFF);
    const unsigned char* Y_ = ws + WS_Y; const v4u* TOKSLOT = (const v4u*)(ws + WS_TOKSLOT); const f32x4* TOKW = (const f32x4*)(ws + WS_TOKW);
    float* OUT = a.out; const bf16* X1B = (const bf16*)(ws + WS_X1B);
    f32x4 gv[4];
#pragma unroll
    for (int j = 0; j < 4; ++j) gv[j] = ((const GAS f32x4*)a.g_final)[F.lane + 64 * j];
    const int gw = F.vcu * 8 + F.wave, NGW = F.G * 8;
    f32x4 vA[4], vB[4]; unsigned yA[4][4], yB[4][4]; v4u sA, sB; f32x4 wA, wB, wC;
    int m = gw;
    P8_SLOTS(sA, wA, m); P8_ISSUE(vA, yA, sA, m); P8_SLOTS(sB, wB, m + NGW);
    for (; m < NTOK; m += 2 * NGW) {
        P8_ISSUE(vB, yB, sB, m + NGW);
        P8_SLOTS(sA, wC, m + 2 * NGW);
        P8_FINISH(vA, yA, wA, m);
        P8_ISSUE(vA, yA, sA, m + 2 * NGW);
        wA = wC; P8_SLOTS(sB, wC, m + 3 * NGW);
        P8_FINISH(vB, yB, wB, m + NGW);
        wB = wC;
    }
}
#undef P8_SLOTS
#undef P8_ISSUE
#undef P8_FINISH

constexpr int N_PHASES = 9;
typedef const __attribute__((address_space(4))) Args* KArgs;
__device__ __forceinline__ Args load_args(KArgs p) { Args a;
    a.x = p->x; a.g_mix = p->g_mix; a.w_in = p->w_in; a.conv_w = p->conv_w; a.b_f = p->b_f; a.w_conv_o = p->w_conv_o; a.w_attn_o = p->w_attn_o; a.w_out = p->w_out; a.g_ffn = p->g_ffn;
    a.w_router = p->w_router; a.b_router = p->b_router; a.w_gate_up = p->w_gate_up; a.b_gate_up = p->b_gate_up; a.w_down = p->w_down; a.b_down = p->b_down; a.g_final = p->g_final;
    a.out = p->out; a.ws = p->ws; a.ph_lo = p->ph_lo; a.ph_hi = p->ph_hi; a.li = p->li; a.pad = 0; return a; }
#define PHASE_ENV() \
    KArgs kp_ = (KArgs)__builtin_amdgcn_kernarg_segment_ptr(); asm volatile("" : "+s"(kp_)); const Args args = load_args(kp_); \
    Frame F; { int t_ = threadIdx.x; asm volatile("" : "+v"(t_)); int bx_ = blockIdx.x; asm volatile("" : "+s"(bx_)); int g_ = gridDim.x; asm volatile("" : "+s"(g_)); \
      F.lds = (LAS unsigned char*)lds; F.tid = t_; F.lane = t_ & 63; F.wave = __builtin_amdgcn_readfirstlane(t_ >> 6); F.G = g_; F.vcu = (g_ % 8 == 0) ? (bx_ % 8) * (g_ / 8) + bx_ / 8 : bx_; F.bx = bx_; } \
    unsigned char* ws = args.ws; (void)ws
__global__ void __launch_bounds__(512, 2) fwd_kernel(Args args_by_value) {
    extern __shared__ __attribute__((aligned(16))) unsigned char lds[];
    int lo, hi; XcdBarrier bar;
    {
        PHASE_ENV();
        for (int u = F.tid; u < (LDS_BYTES - LDSCTL_OFF) / 4; u += 512) ((LAS unsigned*)(F.lds + LDSCTL_OFF))[u] = 0u;
        __syncthreads();
        volatile LAS unsigned* MISC = (volatile LAS unsigned*)(F.lds + MISC_OFF);
        bar = xcd_barrier_post((unsigned*)(ws + WS_CTL) + CW_BAR + args.li * XCD_BAR_WORDS, MISC + 8);
        lo = args.ph_lo; hi = args.ph_hi;
    }
#ifndef PHMASK
#define PHMASK 0x1ff
#endif
#define IN(k) (((PHMASK >> (k)) & 1) && lo <= (k) && (k) < hi)
#define SEAM(k) do { if (lo <= (k) && (k) + 1 < hi) { PHASE_ENV(); xcd_barrier_fill(bar, F, args, ((k) >= 1 && (k) <= 4) && PROBE_REPEAT_PHASE < 0); } } while (0)

    if (IN(0)) { PHASE_ENV(); p0_prologue(F, args); }
    SEAM(0);
    if (IN(1)) {
        PHASE_ENV();
        { EpiG1 E{ws, attn_body::C2};
          SchedGrid S; S.o.init(NTOK / 256, 12, F.G, F.bx); S.A = (unsigned)WS_H; S.B = (unsigned)WS_WIN; S.atile = 256 * 1024 * 2; S.btile = 256 * 1024 * 2;
          pg8::gemm_phase<EpiG1, SchedGrid, false, true>(F.lds + RING_OFF, (const char*)ws, 1024, 1024, 16, S, E); }
        { SchedGrid S; S.o.init(NTOK / 256, 8, F.G, F.bx); S.A = (unsigned)WS_H8; S.B = (unsigned)WS_WG8; S.atile = 256 * 1024; S.btile = 256 * 1024;
          EpiGate E{ws};
          pg8::gemm_phase<EpiGate, SchedGrid, false, true, true>(F.lds + RING_OFF, (const char*)ws, 512, 512, 8, S, E, 0x7b7b7b7b  ); }
    }
    SEAM(1);
    if (IN(2)) {
        { PHASE_ENV(); p2_conv(F, args); }
        PHASE_ENV();
        const attn_body::bf16* Qp = (const attn_body::bf16*)(ws + WS_Q); const attn_body::bf16* Kp = (const attn_body::bf16*)(ws + WS_K); const attn_body::bf16* Vp = (const attn_body::bf16*)(ws + WS_V);
        attn_body::bf16* Op = (attn_body::bf16*)(ws + WS_H) + 512;
        for (int bh = F.vcu; bh < NBATCH * NHEADS; bh += F.G) {
            p2_keybias(F, (const float*)(ws + WS_LOGF), bh, (LAS float*)(F.lds + RING_OFF + attn_body::LDS_KB), (LAS float*)(F.lds + MISC_OFF + 64));
            attn_body::bf16x8 qr[4];
            for (int qb = attn_body::NQB - 1; qb >= 0; --qb) attn_body::attn_unit<60>(bh >> 3, bh & 7, qb, Qp, Kp, Vp, Op, (char*)lds + RING_OFF, qr);
            __syncthreads();
        }
    }
    SEAM(2);
    if (IN(3)) {
        PHASE_ENV();
        SchedMix S; S.o.init(NTOK / 256, 4, F.G, F.bx); S.A = (unsigned)WS_H; S.B = (unsigned)WS_W3; S.atile = 256 * 1024 * 2; S.btile = 256 * 1024 * 2;
        EpiMix E{ws + WS_G8, (bf16*)(ws + WS_MIX)};
        pg8::gemm_phase<EpiMix, SchedMix, false, true>(F.lds + RING_OFF, (const char*)ws, 1024, 1024, 8, S, E);
    }
    SEAM(3);
    if (IN(4)) {
        PHASE_ENV();
        SchedGrid S; S.o.init(NTOK / 256, 4, F.G, F.bx); S.A = (unsigned)WS_MIX; S.B = (unsigned)WS_WOUT; S.atile = 256 * 1024 * 2; S.btile = 256 * 1024 * 2;
        EpiOut E{args.x, (bf16*)(ws + WS_X1B)};
        pg8::gemm_phase<EpiOut, SchedGrid, false, true>(F.lds + RING_OFF, (const char*)ws, 1024, 1024, 16, S, E);
    }
    SEAM(4);
    if (IN(5)) { PHASE_ENV(); p5_router(F, args); cvt_drain(F, args, CVT_NGU); }
    SEAM(5);
    if (IN(6)) {
        PHASE_ENV();
        moe_table(F, args, 8);
        SchedMoe S; S.tab = (const LAS int*)(F.lds + MOETAB_OFF); S.G = F.G; S.c = F.bx; S.nct = 8; S.gather = 1;
        S.A = (unsigned)WS_H2; S.B = (unsigned)WS_WGU; S.list = (unsigned)WS_LIST; S.bexp = 2048u * 1024u; S.atile = 256u * 1024u; S.btile = 256u * 1024u;
        EpiSwiglu E{args.b_gate_up, ws + WS_ACT, (const LAS unsigned char*)(F.lds + GAUX_OFF), F.lds + P5_OFF};
        pg8::gemm_phase<EpiSwiglu, SchedMoe, true, true, true>(F.lds + RING_OFF, (const char*)ws, 512, 512, 8, S, E, 0x7a7a7a7a  , F.lds + GAUX_OFF);
        cvt_drain(F, args, CVT_NCH);
    }
    SEAM(6);
    if (IN(7)) {
        PHASE_ENV();
        moe_table(F, args, 4);
        SchedMoe S; S.tab = (const LAS int*)(F.lds + MOETAB_OFF); S.G = F.G; S.c = F.bx; S.nct = 4; S.gather = 0;
        S.A = (unsigned)WS_ACT; S.B = (unsigned)WS_WD; S.list = 0u; S.bexp = 1024u * 1024u; S.atile = 256u * 1024u; S.btile = 256u * 1024u;
        EpiDown E{args.b_down, ws + WS_Y, F.lds + P5_OFF};
        pg8::gemm_phase<EpiDown, SchedMoe, false, true, true>(F.lds + RING_OFF, (const char*)ws, 512, 512, 8, S, E, 0x7d7d7d7d  );
    }
    SEAM(7);
    if (IN(8)) { PHASE_ENV(); moe_table(F, args, 4); p8_combine(F, args); }
#undef IN
#undef SEAM
}

extern "C" void kernel_launch(void* const* d_in, const int* in_sizes, int n_in, void* d_out, int out_size, void* d_ws, size_t ws_size, hipStream_t stream) {
    static int grid = 0;
    if (grid == 0) {
        if (n_in != 16 || in_sizes[0] != NTOK * DMODEL || out_size != NTOK * DMODEL || ws_size < WS_END) { fprintf(stderr, "kernel_launch: unexpected shapes / workspace (%zu)\n", ws_size); grid = -1; return; }
        int dev = 0, cus = 0, per_cu = 0;
        if (hipGetDevice(&dev) != hipSuccess || hipDeviceGetAttribute(&cus, hipDeviceAttributeMultiprocessorCount, dev) != hipSuccess) { grid = -1; return; }
        if (hipFuncSetAttribute((const void*)fwd_kernel, hipFuncAttributeMaxDynamicSharedMemorySize, LDS_BYTES) != hipSuccess) { grid = -1; return; }
        if (hipOccupancyMaxActiveBlocksPerMultiprocessor(&per_cu, (const void*)fwd_kernel, 512, LDS_BYTES) != hipSuccess || per_cu < 1) fprintf(stderr, "kernel_launch: occupancy query reports %d\n", per_cu);
        (void)hipGetLastError();
        grid = cus;
    }
    if (grid < 0) return;
    if (hipMemsetAsync((char*)d_ws + WS_CTL, 0, CTL_ZERO_BYTES, stream) != hipSuccess) return;
    Args a{};
    a.x = (const float*)d_in[0]; a.g_mix = (const float*)d_in[1]; a.w_in = (const float*)d_in[2]; a.conv_w = (const float*)d_in[3]; a.b_f = (const float*)d_in[4];
    a.w_conv_o = (const float*)d_in[5]; a.w_attn_o = (const float*)d_in[6]; a.w_out = (const float*)d_in[7]; a.g_ffn = (const float*)d_in[8]; a.w_router = (const float*)d_in[9];
    a.b_router = (const float*)d_in[10]; a.w_gate_up = (const float*)d_in[11]; a.b_gate_up = (const float*)d_in[12]; a.w_down = (const float*)d_in[13]; a.b_down = (const float*)d_in[14];
    a.g_final = (const float*)d_in[15];
    a.out = (float*)d_out; a.ws = (unsigned char*)d_ws;
    if (PROBE_REPEAT_PHASE < 0) { a.ph_lo = 0; a.ph_hi = N_PHASES; a.li = 0; hipLaunchKernelGGL(fwd_kernel, dim3(grid), dim3(512), LDS_BYTES, stream, a); }
    else if (PROBE_REPEAT_PHASE == 80) {
        a.ph_lo = 0; a.ph_hi = 8; a.li = 0; hipLaunchKernelGGL(fwd_kernel, dim3(grid), dim3(512), LDS_BYTES, stream, a);
        (void)hipMemcpyAsync((char*)d_ws + WS_ACT, d_out, (size_t)NTOK * DMODEL * 4, hipMemcpyDeviceToDevice, stream);
        a.ph_lo = 8; a.ph_hi = 9; a.li = 1; if (PROBE_REPEAT_PHASE == 8) hipLaunchKernelGGL(fwd_kernel, dim3(grid), dim3(512), LDS_BYTES, stream, a);
        (void)hipMemcpyAsync(d_out, (char*)d_ws + WS_ACT, (size_t)NTOK * DMODEL * 4, hipMemcpyDeviceToDevice, stream);
        a.li = 2; hipLaunchKernelGGL(fwd_kernel, dim3(grid), dim3(512), LDS_BYTES, stream, a);
    }
    else {
        const int k = PROBE_REPEAT_PHASE; const int cuts[4] = {0, k + 1, k + 1, N_PHASES}; const int los[3] = {0, k, k + 1};
        for (int li = 0; li < 3; ++li) { a.ph_lo = los[li]; a.ph_hi = cuts[li + 1]; a.li = li; if (li == 1 && k == 5) (void)hipMemsetAsync((char*)d_ws + WS_CTL + CW_CNT * 4, 0, 256, stream);
            if (a.ph_lo < a.ph_hi) hipLaunchKernelGGL(fwd_kernel, dim3(grid), dim3(512), LDS_BYTES, stream, a); } }
}
```

```cpp
#include <hip/hip_runtime.h>
#include <hip/hip_bf16.h>
#include <cstdio>
#include <cstdint>
#include <cmath>

#ifndef PROBE_REPEAT_PHASE
#define PROBE_REPEAT_PHASE (-1)
#endif

constexpr int NTOK = 65536, DMODEL = 1024, SEQLEN = 2048, NBATCH = 32, NHEADS = 8;
constexpr int NEXP = 32, LISTCAP = NTOK;
constexpr int INCOLS = 5128;
constexpr float RMS_EPS = 1e-5f;

namespace pg8 {
#define PG8_LAS __attribute__((address_space(3)))
typedef unsigned short bf16_t;
typedef short bf16x8 __attribute__((ext_vector_type(8)));
typedef float f32x4 __attribute__((ext_vector_type(4)));
typedef float f32x2 __attribute__((ext_vector_type(2)));
typedef unsigned u32x4 __attribute__((ext_vector_type(4)));
typedef int i32x4 __attribute__((ext_vector_type(4)));
typedef int i32x8 __attribute__((ext_vector_type(8)));
constexpr int BM = 256, BK = 64, HALF = 128, HTB = HALF * BK * 2  , STAGE_BYTES = 8 * HTB, NXCD = 8, WGM = 8;

__host__ __device__ __forceinline__ int lds_byte(int r, int c) { const int st = (r >> 4) * 2 + (c >> 5), rr = r & 15, cc = c & 31, ob = rr * 64 + cc * 2; return st * 1024 + (ob ^ (((ob >> 9) & 1) << 5)); }
__host__ __device__ __forceinline__ void stage_rc(int b, int& R, int& C) { const int st = b / 1024, sb = b % 1024, swz = sb ^ (((sb >> 9) & 1) << 5); R = (st >> 1) * 16 + swz / 64; C = (st & 1) * 32 + (swz % 64) / 2; }
__host__ __device__ __forceinline__ int perm32(int rho) { const int n = rho >> 4, i = rho & 15; return 8 * (i >> 2) + 4 * n + (i & 3); }

struct Unit { unsigned A, B, rows; int pm, pn, e, nvalid, lrows; };

struct GridOrder {
    int nM, nN, nwg, G, c;
    __device__ __forceinline__ void init(int nM_, int nN_, int G_, int c_) { nM = nM_; nN = nN_; nwg = nM * nN; G = G_; c = c_; }
    __device__ __forceinline__ bool map(int i, int& pm, int& pn) const {
        const long L = (long)i * G + c; if (L >= nwg) return false;
        int wgid = (int)L; { const int q = nwg / NXCD, r = nwg % NXCD, xcd = wgid % NXCD, off = wgid / NXCD; wgid = (xcd < r ? xcd * (q + 1) : r * (q + 1) + (xcd - r) * q) + off; }
        const int nig = WGM * nN, gid = wgid / nig, fm = gid * WGM, gsz = (nM - fm) < WGM ? (nM - fm) : WGM;
        pm = fm + ((wgid % nig) % gsz); pn = (wgid % nig) / gsz; return true;
    }
};

__device__ __forceinline__ unsigned cvt_pk_bf16(float lo, float hi) { unsigned r; asm volatile("v_cvt_pk_bf16_f32 %0, %1, %2" : "=v"(r) : "v"(lo), "v"(hi)); return r; }
__device__ __forceinline__ float bf_lo(unsigned w) { return __uint_as_float(w << 16); }
__device__ __forceinline__ float bf_hi(unsigned w) { return __uint_as_float(w & 0xffff0000u); }

template <class Epi, class Sched, bool GATHER, bool ALIGN_EPI, bool FP8 = false>
__device__ __forceinline__ void gemm_phase(PG8_LAS unsigned char* lds, const char* base, const int lda, const int ldb, const int nt, const Sched& S, const Epi& E, const int sc0 = 0x7f7f7f7f, PG8_LAS unsigned char* gaux = nullptr) {
    const int tid = threadIdx.x, wid = __builtin_amdgcn_readfirstlane(tid >> 6), lane = tid & 63, wr = wid >> 2, wc = wid & 3, fr = lane & 15, fq = lane >> 4;
    unsigned voffA[2][2], voffB1[2];
#pragma unroll
    for (int i = 0; i < 2; ++i) { int R, C; stage_rc(tid * 16 + i * 8192, R, C); const int Rb = Epi::PERM ? ((R & ~31) + perm32(R & 31)) : R;
        voffB1[i] = (unsigned)(Rb * ldb + C) * 2u;
#pragma unroll
        for (int h = 0; h < 2; ++h) { voffA[h][i] = (unsigned)((R + (GATHER ? HALF * h : 0)) * lda + C) * 2u; } }
    const unsigned hstepA = GATHER ? 0u : (unsigned)(HALF * lda * 2), hstepB = (unsigned)(HALF * ldb * 2);
    const unsigned kstep = (unsigned)(BK * 2);
    const unsigned ldsw = (unsigned)wid * 1024u;
    const int aoff = lds_byte(wr * 64 + fr, fq * 8), boff = lds_byte(wc * 32 + fr, fq * 8);
#define PG8_SA(b, h) (((b) * 2 + (h)) * HTB)
#define PG8_SB(b, h) ((4 + (b) * 2 + (h)) * HTB)
#define PG8_STAGE(bufoff, gbase, voff) do { _Pragma("unroll") for (int _i = 0; _i < 2; ++_i) \
        __builtin_amdgcn_global_load_lds((const unsigned*)(base + (unsigned)((gbase) + (voff)[_i])), (PG8_LAS unsigned*)(lds + (bufoff) + ldsw + _i * 8192), 16, 0, 0); } while (0)
#define PG8_LDA(dst, b, h) do { _Pragma("unroll") for (int m = 0; m < 4; ++m) _Pragma("unroll") for (int k = 0; k < 2; ++k) dst[m][k] = *(const PG8_LAS bf16x8*)(lds + PG8_SA(b, h) + aoff + m * 2048 + k * 1024); } while (0)
#define PG8_LDB(dst, b, h) do { _Pragma("unroll") for (int n = 0; n < 2; ++n) _Pragma("unroll") for (int k = 0; k < 2; ++k) dst[n][k] = *(const PG8_LAS bf16x8*)(lds + PG8_SB(b, h) + boff + n * 2048 + k * 1024); } while (0)
#define PG8_CAT(X) __builtin_shufflevector(__builtin_bit_cast(i32x4, (X)[0]), __builtin_bit_cast(i32x4, (X)[1]), 0, 1, 2, 3, 4, 5, 6, 7)
#define PG8_MMA(ai, bj, At, Bt) do { __builtin_amdgcn_s_setprio(1); _Pragma("unroll") for (int m = 0; m < 4; ++m) _Pragma("unroll") for (int n = 0; n < 2; ++n) { \
        if constexpr (FP8) acc[ai][bj][m][n] = __builtin_amdgcn_mfma_scale_f32_16x16x128_f8f6f4(PG8_CAT(Bt[n]), PG8_CAT(At[m]), acc[ai][bj][m][n], 0, 0, 0, sc0, 0, sc0); \
        else { _Pragma("unroll") for (int k = 0; k < 2; ++k) acc[ai][bj][m][n] = __builtin_amdgcn_mfma_f32_16x16x32_bf16(Bt[n][k], At[m][k], acc[ai][bj][m][n], 0, 0, 0); } } \
        __builtin_amdgcn_s_setprio(0); } while (0)
#define PG8_WAIT_V(n) asm volatile("s_waitcnt vmcnt(" #n ")" ::: "memory")
#define PG8_WAIT_L(n) asm volatile("s_waitcnt lgkmcnt(" #n ")" ::: "memory")
#define PG8_BAR __builtin_amdgcn_s_barrier()
#define PG8_SCHED __builtin_amdgcn_sched_barrier(0)
#define PG8_LDMA(u, par) __builtin_amdgcn_global_load_lds((const unsigned*)(base + (u).rows + (unsigned)tid * 4u), (PG8_LAS unsigned*)(gaux + (par) * 2048 + wid * 256), 4, 0, 0)
#define PG8_GOFF(u, par, vo) do { int _tid = threadIdx.x; asm volatile("" : "+v"(_tid)); _Pragma("unroll") for (int _i = 0; _i < 2; ++_i) { int _R, _C; stage_rc(_tid * 16 + _i * 8192, _R, _C); \
        _Pragma("unroll") for (int _h = 0; _h < 2; ++_h) { \
        const int _r = _R + HALF * _h; const int _t = ((const PG8_LAS int*)(gaux + (par) * 2048))[2 * (_r < (u).nvalid ? _r : 0)]; (vo)[_h][_i] = (unsigned)(_t * lda + _C) * 2u; } } } while (0)
    Unit cur, nxt; int ui = 0;
    if (!S.next(0, cur)) return;
    f32x4 acc[2][2][4][2];
#pragma unroll
    for (int a = 0; a < 2; ++a)
#pragma unroll
        for (int b = 0; b < 2; ++b)
#pragma unroll
            for (int m = 0; m < 4; ++m)
#pragma unroll
                for (int n = 0; n < 2; ++n) acc[a][b][m][n] = (f32x4){0.f, 0.f, 0.f, 0.f};
    bf16x8 At[4][2], B0[2][2], B1[2][2];
    if constexpr (GATHER) { if constexpr (Epi::BIAS_LDS) E.bias_dma(cur, 0, tid, wid); PG8_LDMA(cur, 0); PG8_WAIT_V(0); PG8_BAR; PG8_GOFF(cur, 0, voffA); cur.lrows = 0; }
    if constexpr (!GATHER && Epi::BIAS_LDS) { E.bias_dma(cur, 0, tid, wid); cur.lrows = 0; }
    unsigned cA = cur.A, cB = cur.B;
    PG8_STAGE(PG8_SB(0, 0), cB, voffB1); PG8_STAGE(PG8_SB(0, 1), cB + hstepB, voffB1); PG8_STAGE(PG8_SA(0, 0), cA, voffA[0]); PG8_STAGE(PG8_SA(0, 1), cA + hstepA, voffA[1]);
    if (wr == 1) PG8_BAR;
    PG8_WAIT_V(2); PG8_BAR;
    PG8_STAGE(PG8_SB(1, 0), cB + kstep, voffB1); PG8_STAGE(PG8_SA(1, 0), cA + kstep, voffA[0]); PG8_STAGE(PG8_SB(1, 1), cB + kstep + hstepB, voffB1);
    PG8_WAIT_V(6); PG8_BAR;
    for (;;) {
        const bool has_next = S.next(ui + 1, nxt);
        const unsigned nA = has_next ? nxt.A : cA, nB = has_next ? nxt.B : cB;
        const int gbn = (ui + 1) % 3;
        if constexpr (!GATHER && Epi::BIAS_LDS) { if (has_next) { E.bias_dma(nxt, gbn, tid, wid); nxt.lrows = gbn * 2048; } }
        if constexpr (GATHER) { if (has_next) { if constexpr (Epi::BIAS_LDS) E.bias_dma(nxt, gbn, tid, wid); PG8_LDMA(nxt, gbn); nxt.lrows = gbn * 2048; } }
        for (int t = 0; t < nt; t += 2) {
            const bool last = (t == nt - 2);
            const unsigned a1 = cA + (unsigned)(t + 1) * kstep;
            const unsigned a2 = last ? nA : cA + (unsigned)(t + 2) * kstep, b2 = last ? nB : cB + (unsigned)(t + 2) * kstep;
            const unsigned a3 = a2 + kstep, b3 = b2 + kstep;
            PG8_LDB(B0, 0, 0); PG8_LDB(B1, 0, 1); PG8_SCHED; PG8_LDA(At, 0, 0); PG8_STAGE(PG8_SA(1, 1), a1 + hstepA, voffA[1]);
            if constexpr (GATHER) { if (last && has_next) { PG8_GOFF(nxt, gbn, voffA); } }
            PG8_WAIT_V(8); PG8_WAIT_L(0); PG8_BAR; PG8_MMA(0, 0, At, B0); PG8_MMA(0, 1, At, B1); PG8_BAR; PG8_SCHED;
            PG8_LDA(At, 0, 1); PG8_STAGE(PG8_SB(0, 0), b2, voffB1); PG8_STAGE(PG8_SB(0, 1), b2 + hstepB, voffB1); PG8_STAGE(PG8_SA(0, 0), a2, voffA[0]);
            PG8_WAIT_V(8); PG8_WAIT_L(0); PG8_BAR; PG8_MMA(1, 0, At, B0); PG8_MMA(1, 1, At, B1); PG8_BAR; PG8_SCHED;
            PG8_LDB(B0, 1, 0); PG8_LDB(B1, 1, 1); PG8_SCHED; PG8_LDA(At, 1, 0); PG8_STAGE(PG8_SA(0, 1), a2 + hstepA, voffA[1]);
            PG8_WAIT_V(8); PG8_WAIT_L(0); PG8_BAR; PG8_MMA(0, 0, At, B0); PG8_MMA(0, 1, At, B1); PG8_BAR; PG8_SCHED;
            PG8_LDA(At, 1, 1); PG8_STAGE(PG8_SB(1, 0), b3, voffB1); PG8_STAGE(PG8_SB(1, 1), b3 + hstepB, voffB1); PG8_STAGE(PG8_SA(1, 0), a3, voffA[0]);
            PG8_WAIT_V(8); PG8_WAIT_L(0); PG8_BAR; PG8_MMA(1, 0, At, B0); PG8_MMA(1, 1, At, B1); PG8_BAR; PG8_SCHED;
        }
        if constexpr (ALIGN_EPI) { if (wr == 0) PG8_BAR; }
        const bool keep = E(acc, cur);
        if (!has_next) break;
        if (!keep) {
            const unsigned z_ = (unsigned)(uintptr_t)(lds + STAGE_BYTES);
#pragma unroll
            for (int a = 0; a < 2; ++a)
#pragma unroll
                for (int b = 0; b < 2; ++b)
#pragma unroll
                    for (int m = 0; m < 4; ++m)
#pragma unroll
                        for (int n = 0; n < 2; ++n) asm volatile("ds_read_b128 %0, %1" : "=v"(acc[a][b][m][n]) : "v"(z_) : "memory");
        }
        cur = nxt; cA = nA; cB = nB; ++ui;
        if constexpr (ALIGN_EPI) { if (wr == 1) PG8_BAR; }
    }
    PG8_WAIT_V(0);
    if constexpr (!ALIGN_EPI) { if (wr == 0) PG8_BAR; }
    PG8_BAR;
#undef PG8_SA
#undef PG8_SB
#undef PG8_STAGE
#undef PG8_LDA
#undef PG8_LDB
#undef PG8_MMA
#undef PG8_CAT
#undef PG8_WAIT_V
#undef PG8_WAIT_L
#undef PG8_BAR
#undef PG8_SCHED
#undef PG8_GOFF
#undef PG8_LDMA
}
}

namespace attn_body {
using bf16=__hip_bfloat16;
using bf16x8=__attribute__((ext_vector_type(8)))short;
using s16x4=__attribute__((ext_vector_type(4)))short;
using f32x16=__attribute__((ext_vector_type(16)))float;
using f32x4v=__attribute__((ext_vector_type(4)))float;
using u32x4=__attribute__((ext_vector_type(4)))unsigned;
constexpr int BATCH=NBATCH,NHEAD=NHEADS,SEQ=SEQLEN,D=64,DM=NHEAD*D,ODM=1024;
constexpr int NW=8,QBLK=32,QB=QBLK*NW,KVBLK=64,NQB=SEQ/QB;
__device__ __forceinline__ int crow(int r,int hi){return (r&3)+8*(r>>2)+4*hi;}
#define SBAR() __builtin_amdgcn_sched_barrier(0)
__device__ __forceinline__ void cmask(f32x16&p0,f32x16&p1,int jb,int qrel,int hi){
  const float NEG=-INFINITY; int kb=64*jb+4*hi;
  #pragma unroll
  for(int r=0;r<16;++r){int kv=kb+(r&3)+8*(r>>2); if(kv>qrel)p0[r]=NEG; if(kv+32>qrel)p1[r]=NEG;}
}
constexpr int NSLOT=3, SLOTB=8192;
constexpr int LDS_K=0, LDS_V=NSLOT*SLOTB, LDS_WS=2*NSLOT*SLOTB, LDS_OST=LDS_WS+NW*64*4, LDS_KB=LDS_OST+NW*4096, LDS_BYTES=LDS_KB+SEQ*4;
constexpr float C2=0.125f*1.4426950408889634f;
__device__ __forceinline__ void glds16(const void*gsrc,unsigned lds_dst){unsigned keep;
  asm volatile("s_mov_b32 %0, m0\n\ts_mov_b32 m0, %2\n\ts_nop 0\n\tglobal_load_lds_dwordx4 %1, off\n\ts_mov_b32 m0, %0":"=&s"(keep):"v"(gsrc),"s"(lds_dst):"memory");}
__device__ __forceinline__ float max3f(float a,float b,float c){float r;asm("v_max3_f32 %0, %1, %2, %3":"=v"(r):"v"(a),"v"(b),"v"(c));return r;}
__device__ __forceinline__ float max2f(float a,float b){float r;asm("v_max_f32_e32 %0, %1, %2":"=v"(r):"v"(a),"v"(b));return r;}
__device__ __forceinline__ float fadd_s(float a,float b){float r;asm("v_add_f32_e32 %0, %1, %2":"=v"(r):"v"(a),"v"(b));return r;}
__device__ __forceinline__ float fsub_s(float a,float b){float r;asm("v_sub_f32_e32 %0, %1, %2":"=v"(r):"v"(a),"v"(b));return r;}
typedef float f32x2_t __attribute__((ext_vector_type(2))); typedef __bf16 bf16x2_t __attribute__((ext_vector_type(2)));
__device__ __forceinline__ unsigned cvtpk_s(float lo,float hi){f32x2_t v={lo,hi};bf16x2_t b=__builtin_convertvector(v,bf16x2_t);return __builtin_bit_cast(unsigned,b);}
#define WAIT_BAR(N) asm volatile("s_waitcnt vmcnt(" #N ") lgkmcnt(0)\n\ts_barrier":::"memory")

__device__ __forceinline__ void qkt(f32x16&p0,f32x16&p1,const char*Kslot,const bf16x8*qr,int r32,int hi){
  const char*kb=Kslot+hi*1024+r32*16;
  #pragma unroll
  for(int d0=0;d0<4;++d0){
    const bf16x8 b0=*reinterpret_cast<const bf16x8*>(kb+d0*2048);
    const bf16x8 b1=*reinterpret_cast<const bf16x8*>(kb+d0*2048+512);
    p0=__builtin_amdgcn_mfma_f32_32x32x16_bf16(b0,qr[d0],p0,0,0,0);p1=__builtin_amdgcn_mfma_f32_32x32x16_bf16(b1,qr[d0],p1,0,0,0);}
}
typedef __attribute__((address_space(3))) const char* lds_cptr;
typedef short v4i16_t __attribute__((ext_vector_type(4)));
__device__ __forceinline__ void kload8(bf16x8*kf,lds_cptr kp){
  kf[0]=*(const __attribute__((address_space(3))) bf16x8*)(kp);      kf[1]=*(const __attribute__((address_space(3))) bf16x8*)(kp+512);
  kf[2]=*(const __attribute__((address_space(3))) bf16x8*)(kp+2048); kf[3]=*(const __attribute__((address_space(3))) bf16x8*)(kp+2560);
  kf[4]=*(const __attribute__((address_space(3))) bf16x8*)(kp+4096); kf[5]=*(const __attribute__((address_space(3))) bf16x8*)(kp+4608);
  kf[6]=*(const __attribute__((address_space(3))) bf16x8*)(kp+6144); kf[7]=*(const __attribute__((address_space(3))) bf16x8*)(kp+6656);
}
__device__ __forceinline__ void kload2(bf16x8*kf,lds_cptr kp,int j){ kf[2*j]=*(const __attribute__((address_space(3))) bf16x8*)(kp+j*2048); kf[2*j+1]=*(const __attribute__((address_space(3))) bf16x8*)(kp+j*2048+512); }
__device__ __forceinline__ s16x4 vtr(lds_cptr p){ return __builtin_bit_cast(s16x4,__builtin_amdgcn_ds_read_tr16_b64_v4i16((__attribute__((address_space(3))) v4i16_t*)p)); }
__device__ __forceinline__ float rowmax(const f32x16&p0,const f32x16&p1){
  float a=max3f(p0[0],p0[1],p1[0]),b=max3f(p0[2],p0[3],p1[1]);a=max3f(a,p1[2],p1[3]);
  #pragma unroll
  for(int r=4;r<16;r+=4){a=max3f(a,p0[r],p0[r+1]);b=max3f(b,p0[r+2],p0[r+3]);a=max3f(a,p1[r],p1[r+1]);b=max3f(b,p1[r+2],p1[r+3]);}
  const float m=max2f(a,b);
  auto rr=__builtin_amdgcn_permlane32_swap(__float_as_uint(m),__float_as_uint(m),false,false);
  return max2f(__uint_as_float(rr[0]),__uint_as_float(rr[1]));
}
__device__ __forceinline__ void pv(f32x16*o,int vb,bf16x8 pa0,bf16x8 pa1,bf16x8 pa2,bf16x8 pa3){
  #pragma unroll
  for(int d0=0;d0<2;++d0){s16x4 lo[4],hi[4];
    #pragma unroll
    for(int ks=0;ks<4;++ks){
      asm volatile("ds_read_b64_tr_b16 %0,%1 offset:%c2":"=&v"(lo[ks]):"v"(vb),"i"(d0*4096+ks*1024):"memory");
      asm volatile("ds_read_b64_tr_b16 %0,%1 offset:%c2":"=&v"(hi[ks]):"v"(vb),"i"(d0*4096+ks*1024+512):"memory");}
    asm volatile("s_waitcnt lgkmcnt(0)":::"memory");SBAR();
    #define PK(k) (bf16x8){lo[k][0],lo[k][1],lo[k][2],lo[k][3],hi[k][0],hi[k][1],hi[k][2],hi[k][3]}
    o[d0]=__builtin_amdgcn_mfma_f32_32x32x16_bf16(pa0,PK(0),o[d0],0,0,0);
    o[d0]=__builtin_amdgcn_mfma_f32_32x32x16_bf16(pa1,PK(1),o[d0],0,0,0);
    o[d0]=__builtin_amdgcn_mfma_f32_32x32x16_bf16(pa2,PK(2),o[d0],0,0,0);
    o[d0]=__builtin_amdgcn_mfma_f32_32x32x16_bf16(pa3,PK(3),o[d0],0,0,0);
    #undef PK
  }
}
#define ATTN_STORE16(p,v) (*(u32x4*)(p)=(v))
template<int THRL> __device__ __forceinline__ void attn_unit(int b,int h,int qb,const bf16*Q,const bf16*__restrict__ K,const bf16*__restrict__ V,bf16*O,char*shm,bf16x8(&qr)[4]){
  int tid=threadIdx.x; asm volatile("":"+v"(tid));
  const int lane=tid&63,r32=lane&31,hi=lane>>5; const int wid=__builtin_amdgcn_readfirstlane(tid>>6);
  const long rowbase=(long)b*SEQ; const int q0=qb*QB;
  const bf16*Qw=Q+(rowbase+q0+wid*QBLK)*DM+h*D;
  const bf16*Kh=K+rowbase*DM+h*D,*Vh=V+rowbase*DM+h*D;
  const unsigned lds0=(unsigned)(uintptr_t)shm;
  float*wsf=(float*)(shm+LDS_WS)+wid*64;
  const bf16*ksrc=Kh+(long)lane*DM+wid*8;
  const bf16*vsrc=Vh+(long)(16*(wid&3)+(lane>>2))*DM+(wid>>2)*32+(lane&3)*8;
  const unsigned kdst=lds0+LDS_K+wid*1024, vdst=lds0+LDS_V+wid*1024;
  #define DMA_K(t,slot) glds16(ksrc+(long)(t)*KVBLK*DM,(unsigned)__builtin_amdgcn_readfirstlane(kdst+(slot)))
  #define DMA_V(t,slot) glds16(vsrc+(long)(t)*KVBLK*DM,(unsigned)__builtin_amdgcn_readfirstlane(vdst+(slot)))
  const int vb0=(int)(lds0+LDS_V)+((lane>>4)&1)*32+(lane&3)*8+(4*hi+((lane&15)>>2))*64;
  const char*Kbase=shm+LDS_K; bf16x8 kf[8];
  const lds_cptr shm3=(lds_cptr)shm; const lds_cptr kp0=shm3+LDS_K+hi*1024+r32*16; const lds_cptr vp0=shm3+LDS_V+((lane>>4)&1)*32+(lane&3)*8+(4*hi+((lane&15)>>2))*64;
  const lds_cptr kbp=shm3+LDS_KB+hi*16;
  const int NT=(q0+QB)/KVBLK;
  if(qb==NQB-1){DMA_K(0,0);DMA_V(0,0);DMA_K(1,SLOTB);}
  if(qb==NQB-1){
    #pragma unroll
    for(int d0=0;d0<4;++d0)qr[d0]=*reinterpret_cast<const bf16x8*>(&Qw[(long)r32*DM+d0*16+hi*8]); }
  float mhat=0.f,l_reg=0.f;f32x16 o[2];o[0]=f32x16{};o[1]=f32x16{};
  const int qrel=wid*QBLK+r32;
  #define CINIT(X0,X1,tt) do{ const lds_cptr p_=kbp+(tt)*256; \
    _Pragma("unroll") for(int g_=0;g_<4;++g_){ \
      const f32x4v a_=*(const __attribute__((address_space(3))) f32x4v*)(p_+32*g_); const f32x4v b_=*(const __attribute__((address_space(3))) f32x4v*)(p_+128+32*g_); \
      X0[4*g_]=a_[0]-mhat; X0[4*g_+1]=a_[1]-mhat; X0[4*g_+2]=a_[2]-mhat; X0[4*g_+3]=a_[3]-mhat; \
      X1[4*g_]=b_[0]-mhat; X1[4*g_+1]=b_[1]-mhat; X1[4*g_+2]=b_[2]-mhat; X1[4*g_+3]=b_[3]-mhat; } }while(0)
  #define CMASK(P0,P1,t) do{int jb_=(t)-(NT-4); if(jb_>=0)cmask(P0,P1,jb_,qrel,hi);}while(0)
  bool resc=false;
  #define START(P0,P1) do{ const float rm=rowmax(P0,P1); resc=false; \
    { const float dl=rm; mhat=fadd_s(mhat,dl); \
      _Pragma("unroll") for(int r=0;r<16;++r){P0[r]=fsub_s(P0[r],dl);P1[r]=fsub_s(P1[r],dl);} } \
    _Pragma("unroll") for(int r=0;r<16;++r)P0[r]=__builtin_amdgcn_exp2f(P0[r]); }while(0)
  #define RESC() do{ if(resc){ asm volatile("s_waitcnt lgkmcnt(0)":::"memory"); \
      _Pragma("unroll") for(int d_=0;d_<2;++d_) _Pragma("unroll") for(int r=0;r<16;++r)o[d_][r]*=wsf[crow(r,hi)]; } }while(0)
  f32x16 pA0,pA1,pB0,pB1;
  int sl_prev=0,sl_cur=0,sl_next=SLOTB;
  #define ROT() do{sl_prev=sl_cur;sl_cur=sl_next;sl_next=(sl_next==(NSLOT-1)*SLOTB)?0:sl_next+SLOTB;}while(0)
  DMA_K(2,2*SLOTB);
  CINIT(pA0,pA1,0);
  WAIT_BAR(3);
  qkt(pA0,pA1,Kbase,qr,r32,hi);asm volatile("s_nop 15\n\ts_nop 7":"+v"(pA0),"+v"(pA1));CMASK(pA0,pA1,0);
  START(pA0,pA1);
  _Pragma("unroll") for(int r=0;r<16;++r)pA1[r]=__builtin_amdgcn_exp2f(pA1[r]);
  CINIT(pB0,pB1,1);
  WAIT_BAR(0);
  DMA_K(3,0);DMA_V(1,SLOTB);
  ROT();
  kload8(kf,kp0+sl_cur);
  WAIT_BAR(2);
  s16x4 vlo[8],vhi[8]; u32x4 pw0,pw1,pw2,pw3;
  #define PKW(P,B) cvtpk_s(P[B],P[B+1])
  #define PAF(k) __builtin_bit_cast(bf16x8,pw##k)
  #define VFR(i) (bf16x8){vlo[i][0],vlo[i][1],vlo[i][2],vlo[i][3],vhi[i][0],vhi[i][1],vhi[i][2],vhi[i][3]}
  #define PIN(x) asm volatile("":"+v"(x))
  #define MX3(a,b,c) __builtin_fmaxf(__builtin_fmaxf((a),(b)),(c))
  #define GAPA(MF,A0,A1,A2,A3,W0,W1,PW) do{ MF; sacc+=A0; sacc+=A1; sacc+=A2; sacc+=A3; PIN(sacc); W0; W1; PIN(PW); SBAR(); }while(0)
  #define EX(v) __builtin_amdgcn_exp2f(v)
  #define GAPB(MF,X,B) do{ MF; X[B]=EX(X[B]); X[B+1]=EX(X[B+1]); X[B+2]=EX(X[B+2]); X[B+3]=EX(X[B+3]); PIN(X); SBAR(); }while(0)
  #define VRD(i) do{ vlo[i]=vtr(vp_+(((i)>>2)*4096+((i)&3)*1024)); vhi[i]=vtr(vp_+(((i)>>2)*4096+((i)&3)*1024+512)); }while(0)
  #define KRD(G,j) do{ if(G){ kload2(kf,kp0+sl_next,j); SBAR(); } }while(0)
  #define STEP(C0,C1,P0,P1,t,GK,GV,GL) do{ SBAR(); \
    const lds_cptr vp_=vp0+sl_prev; \
    VRD(0); SBAR(); float sacc=(P0[0]+P0[1]); \
    GAPA(C0=__builtin_amdgcn_mfma_f32_32x32x16_bf16(kf[0],qr[0],C0,0,0,0), P0[2],P0[3],P0[4],P0[5],     pw0[0]=PKW(P0,0), pw0[1]=PKW(P0,2), pw0); \
    VRD(4); SBAR(); GAPA(C1=__builtin_amdgcn_mfma_f32_32x32x16_bf16(kf[1],qr[0],C1,0,0,0), P0[6],P0[7],P0[8],P0[9],     pw0[2]=PKW(P0,4), pw0[3]=PKW(P0,6), pw0); \
    VRD(1); SBAR(); GAPA(C0=__builtin_amdgcn_mfma_f32_32x32x16_bf16(kf[2],qr[1],C0,0,0,0),   P0[10],P0[11],P0[12],P0[13], pw1[0]=PKW(P0,8), pw1[1]=PKW(P0,10), pw1); \
    VRD(5); SBAR(); GAPA(C1=__builtin_amdgcn_mfma_f32_32x32x16_bf16(kf[3],qr[1],C1,0,0,0),   P0[14],P0[15],P1[0],P1[1],   pw1[2]=PKW(P0,12),pw1[3]=PKW(P0,14), pw1); \
    VRD(2); SBAR(); GAPA(C0=__builtin_amdgcn_mfma_f32_32x32x16_bf16(kf[4],qr[2],C0,0,0,0),   P1[2],P1[3],P1[4],P1[5],     pw2[0]=PKW(P1,0), pw2[1]=PKW(P1,2), pw2); \
    VRD(6); SBAR(); GAPA(C1=__builtin_amdgcn_mfma_f32_32x32x16_bf16(kf[5],qr[2],C1,0,0,0),   P1[6],P1[7],P1[8],P1[9],     pw2[2]=PKW(P1,4), pw2[3]=PKW(P1,6), pw2); \
    VRD(3); SBAR(); GAPA(C0=__builtin_amdgcn_mfma_f32_32x32x16_bf16(kf[6],qr[3],C0,0,0,0),   P1[10],P1[11],P1[12],P1[13], pw3[0]=PKW(P1,8), pw3[1]=PKW(P1,10), pw3); \
    VRD(7); SBAR(); GAPA(C1=__builtin_amdgcn_mfma_f32_32x32x16_bf16(kf[7],qr[3],C1,0,0,0),   P1[14],P1[15],0.f,0.f,       pw3[2]=PKW(P1,12),pw3[3]=PKW(P1,14), pw3); \
    l_reg+=sacc; \
    if(GK){DMA_K((t)+3,sl_cur);} if(GV){DMA_V((t)+1,sl_next);} \
    CMASK(C0,C1,t); \
    { float a=MX3(C0[0],C0[1],C1[0]),b=MX3(C0[2],C0[3],C1[1]); a=MX3(a,C1[2],C1[3]); \
      _Pragma("unroll") for(int r=4;r<16;r+=4){a=MX3(a,C0[r],C0[r+1]);b=MX3(b,C0[r+2],C0[r+3]);a=MX3(a,C1[r],C1[r+1]);b=MX3(b,C1[r+2],C1[r+3]);} \
      float rm=__builtin_fmaxf(a,b); { auto rr=__builtin_amdgcn_permlane32_swap(__float_as_uint(rm),__float_as_uint(rm),false,false); rm=__builtin_fmaxf(__uint_as_float(rr[0]),__uint_as_float(rr[1])); } \
      resc=false; \
      if(__builtin_expect(__any(rm>(float)THRL),0)){ const float dl=__builtin_fmaxf(rm,0.f); mhat+=dl; \
        _Pragma("unroll") for(int r=0;r<16;++r){C0[r]-=dl;C1[r]-=dl;} \
        const float f=__builtin_amdgcn_exp2f(-dl); l_reg*=f; if(hi==0)wsf[r32]=f; resc=true; } } \
    SBAR(); \
    GAPB(o[0]=__builtin_amdgcn_mfma_f32_32x32x16_bf16(PAF(0),VFR(0),o[0],0,0,0), C0,0); \
    GAPB(o[1]=__builtin_amdgcn_mfma_f32_32x32x16_bf16(PAF(0),VFR(4),o[1],0,0,0), C0,4); \
    KRD(GL,0); GAPB(o[0]=__builtin_amdgcn_mfma_f32_32x32x16_bf16(PAF(1),VFR(1),o[0],0,0,0), C0,8); \
    KRD(GL,1); GAPB(o[1]=__builtin_amdgcn_mfma_f32_32x32x16_bf16(PAF(1),VFR(5),o[1],0,0,0), C0,12); \
    KRD(GL,2); GAPB(o[0]=__builtin_amdgcn_mfma_f32_32x32x16_bf16(PAF(2),VFR(2),o[0],0,0,0), C1,0); \
    KRD(GL,3); GAPB(o[1]=__builtin_amdgcn_mfma_f32_32x32x16_bf16(PAF(2),VFR(6),o[1],0,0,0), C1,4); \
    GAPB(o[0]=__builtin_amdgcn_mfma_f32_32x32x16_bf16(PAF(3),VFR(3),o[0],0,0,0), C1,8); \
    GAPB(o[1]=__builtin_amdgcn_mfma_f32_32x32x16_bf16(PAF(3),VFR(7),o[1],0,0,0), C1,12); \
    if(GL){ CINIT(P0,P1,(t)+1); } \
    }while(0)
  int t=1;
  #undef CMASK
  #define CMASK(P0,P1,t) do{}while(0)
  for(;t+5<NT;t+=2){
    STEP(pB0,pB1,pA0,pA1,t,true,true,true);     WAIT_BAR(2); RESC(); ROT();
    STEP(pA0,pA1,pB0,pB1,t+1,true,true,true);   WAIT_BAR(2); RESC(); ROT();
  }
  #undef CMASK
  #define CMASK(P0,P1,t) do{int jb_=(t)-(NT-4); if(jb_>=0)cmask(P0,P1,jb_,qrel,hi);}while(0)
  #define ENDW(tt) do{ if((tt)+3<NT){WAIT_BAR(2);} else if((tt)+2<NT){WAIT_BAR(1);} else {WAIT_BAR(0);} }while(0)
  for(;t+1<NT;t+=2){
    STEP(pB0,pB1,pA0,pA1,t,(t+3<NT),(t+1<NT),(t+1<NT));       ENDW(t);   RESC(); ROT();
    STEP(pA0,pA1,pB0,pB1,t+1,(t+4<NT),(t+2<NT),(t+2<NT));     ENDW(t+1); RESC(); ROT();
  }
  STEP(pB0,pB1,pA0,pA1,NT-1,false,false,false); RESC();
  { float sacc=pB0[0]+pB0[1]; _Pragma("unroll") for(int r=2;r<16;++r)sacc+=pB0[r]; _Pragma("unroll") for(int r=0;r<16;++r)sacc+=pB1[r]; l_reg+=sacc;
    pw0=(u32x4){PKW(pB0,0),PKW(pB0,2),PKW(pB0,4),PKW(pB0,6)};pw1=(u32x4){PKW(pB0,8),PKW(pB0,10),PKW(pB0,12),PKW(pB0,14)};pw2=(u32x4){PKW(pB1,0),PKW(pB1,2),PKW(pB1,4),PKW(pB1,6)};pw3=(u32x4){PKW(pB1,8),PKW(pB1,10),PKW(pB1,12),PKW(pB1,14)};
    SBAR(); pv(o,vb0+sl_cur,PAF(0),PAF(1),PAF(2),PAF(3)); }
  if(qb>0){ asm volatile("s_barrier":::"memory"); DMA_K(0,0);DMA_V(0,0);DMA_K(1,SLOTB);
    const bf16*Qn=Qw-(long)QB*DM;
    #pragma unroll
    for(int d0=0;d0<4;++d0)qr[d0]=*reinterpret_cast<const bf16x8*>(&Qn[(long)r32*DM+d0*16+hi*8]); }
  #undef PKW
  #undef PAF
  #undef VFR
  #undef PIN
  #undef MX3
  #undef GAPA
  #undef GAPB
  #undef EX
  #undef VRD
  #undef KRD
  #undef STEP
  #undef ENDW
  {auto rr=__builtin_amdgcn_permlane32_swap(__float_as_uint(l_reg),__float_as_uint(l_reg),false,false);l_reg=__uint_as_float(rr[0])+__uint_as_float(rr[1]);}
  if(hi==0)wsf[32+r32]=l_reg;asm volatile("s_waitcnt lgkmcnt(0)":::"memory");
  float rli[16];
  #pragma unroll
  for(int r=0;r<16;++r)rli[r]=__builtin_amdgcn_rcpf(wsf[32+crow(r,hi)]);
  bf16*Ow=O+(rowbase+q0+wid*QBLK)*ODM+h*D;
  { bf16*stg=(bf16*)(shm+LDS_OST)+wid*2048;
    #pragma unroll
    for(int r=0;r<16;++r){const int orow=crow(r,hi);
      #pragma unroll
      for(int d0=0;d0<2;++d0)stg[orow*64+d0*32+r32]=__float2bfloat16(o[d0][r]*rli[r]);}
    asm volatile("s_waitcnt lgkmcnt(0)":::"memory");
    #pragma unroll
    for(int i=0;i<4;++i){const int row=i*8+(lane>>3),ch=lane&7; const u32x4 v=*(const u32x4*)(stg+row*64+ch*8); ATTN_STORE16(Ow+(long)row*ODM+ch*8,v);} }
  asm volatile("s_waitcnt lgkmcnt(0)\n\ts_barrier":::"memory");
  #undef DMA_K
  #undef DMA_V
  #undef CMASK
  #undef CINIT
  #undef START
  #undef RESC
  #undef ROT
}
#undef SBAR
#undef WAIT_BAR
}

constexpr size_t MiB = 1u << 20;
constexpr size_t WS_CTL = 0, CTL_ZERO_BYTES = 96 * 1024;
constexpr size_t WS_WIN = 2 * MiB;
constexpr size_t WS_W3 = 12 * MiB;
constexpr size_t WS_WOUT = 14 * MiB;
constexpr size_t WS_WGU = 16 * MiB;
constexpr size_t WS_WD = 80 * MiB;
constexpr size_t WS_H = 112 * MiB;
constexpr size_t WS_CB = 240 * MiB;
constexpr size_t WS_UC = 304 * MiB;
constexpr size_t WS_MIX = 688 * MiB;
constexpr size_t WS_Q = 368 * MiB, WS_K = 432 * MiB, WS_V = 496 * MiB;
constexpr size_t WS_R = 560 * MiB;
constexpr size_t WS_G8 = WS_R;
constexpr size_t WS_ACT = 304 * MiB;
constexpr size_t WS_Y = 568 * MiB;
constexpr size_t WS_H8 = 816 * MiB;
constexpr size_t WS_WG8 = 880 * MiB;
constexpr size_t WS_X1B = 112 * MiB;
constexpr size_t WS_H2 = 240 * MiB;
constexpr size_t WS_LOGF = 968 * MiB;
constexpr size_t WS_LIST = 970 * MiB;
constexpr size_t WS_TOKSLOT = 986 * MiB;
constexpr size_t WS_TOKW = 987 * MiB;
constexpr size_t WS_END = 988 * MiB;
static_assert(WS_H2 + (size_t)NTOK * 1024 <= WS_ACT && WS_ACT + (size_t)1056 * 256 * 1024 <= WS_Y && WS_Y + (size_t)1056 * 256 * 1024 <= WS_LOGF && WS_X1B + (size_t)NTOK * 2048 <= WS_H2 && WS_H2 == WS_CB && WS_X1B == WS_H, "MoE buffers");
constexpr int CW_BAR = 4096;
constexpr int CW_CNT = 16384;
constexpr int CW_CVT = 20480;
constexpr int CVT_NGU = 32 * 8 * 64 / 8;
constexpr int CVT_NCH = CVT_NGU + 32 * 8 * 32 / 8;
#ifndef CVT_STOP
#define CVT_STOP 3u
#endif

constexpr int RING_OFF = 0, RING_BYTES = 131072;
constexpr int LDSCTL_OFF = RING_BYTES, MISC_OFF = LDSCTL_OFF + 320;
constexpr int MOETAB_OFF = LDSCTL_OFF + 1024;
constexpr int P5_OFF = LDSCTL_OFF + 2048;
constexpr int GAUX_OFF = LDSCTL_OFF + 8192;
constexpr int LDS_BYTES = 147456;
static_assert(P5_OFF + (64 + 1024) * 4 <= GAUX_OFF && GAUX_OFF + 8192 <= LDS_BYTES && attn_body::LDS_BYTES <= RING_BYTES, "LDS map");

#define GAS __attribute__((address_space(1)))
#define LAS __attribute__((address_space(3)))
typedef unsigned short bf16;
typedef unsigned v4u __attribute__((ext_vector_type(4)));
typedef unsigned v2u __attribute__((ext_vector_type(2)));
typedef float f32x4 __attribute__((ext_vector_type(4)));
typedef GAS unsigned gu32;
#define RLX_AGENT __ATOMIC_RELAXED, __HIP_MEMORY_SCOPE_AGENT
#define LDS_WAIT() asm volatile("s_waitcnt lgkmcnt(0)" ::: "memory")
#define VM_WAIT() asm volatile("s_waitcnt vmcnt(0)" ::: "memory")
__device__ __forceinline__ unsigned f2bf(float f) { unsigned u = __builtin_bit_cast(unsigned, f); return (u + 0x7fffu + ((u >> 16) & 1u)) >> 16; }
__device__ __forceinline__ unsigned pk2(float lo, float hi) { return f2bf(lo) | (f2bf(hi) << 16); }

#define XB_TMO      128
#define XB_MISMAP   192
#define XB_XCNT(j)  (256  + 64 * (j))
#define XB_XSUB(j)  (1280 + 64 * (j))
#define XB_XGEN(j)  (2304 + 64 * (j))
#define XB_TOP      3328
#define XB_TOPGEN   3392
#define XCD_BAR_WORDS 3456
#define XB_SPIN_CAP (1u << 18)
__device__ __forceinline__ unsigned xb_ld(unsigned* p)              { return __hip_atomic_load(p, __ATOMIC_RELAXED, __HIP_MEMORY_SCOPE_AGENT); }
__device__ __forceinline__ unsigned xb_add(unsigned* p, unsigned v) { return __hip_atomic_fetch_add(p, v, __ATOMIC_RELAXED, __HIP_MEMORY_SCOPE_AGENT); }
__device__ __forceinline__ unsigned xb_xcc_id() { return (unsigned)__builtin_amdgcn_s_getreg((3 << 11) | 20) & 0xFu; }
#define XB_SPIN(cond, bar) do { unsigned _sp = 0; while (cond) { __builtin_amdgcn_s_sleep(1); \
    if ((++_sp & 255u) == 0u) { if (xb_ld(&(bar)[XB_TMO])) break; if (_sp > XB_SPIN_CAP) { atomicAdd(&(bar)[XB_TMO], 1u); break; } } } } while (0)
struct XcdBarrier { unsigned* bar; unsigned x; volatile LAS unsigned* st; };
__device__ __forceinline__ XcdBarrier xcd_barrier_post(unsigned* bar, volatile LAS unsigned* st) {
    XcdBarrier b; b.bar = bar; b.x = xb_xcc_id(); b.st = st;
    if (threadIdx.x == 0) {
        if (b.x != (blockIdx.x & 7u)) { const unsigned r = xb_add(&bar[XB_MISMAP], 1u); asm volatile("" :: "v"(r)); }
        (void)xb_add(&bar[XB_XCNT(b.x)], 1u);
    }
    return b;
}
__device__ __forceinline__ void xcd_barrier_complete(unsigned* bar, unsigned x, unsigned& nloc, unsigned& nx) {
    const unsigned G = gridDim.x * gridDim.y * gridDim.z;
    unsigned sum, cnt, mine, even, sp = 0u;
    for (;;) {
        sum = 0u; cnt = 0u; mine = 0u; even = 1u;
#pragma unroll
        for (unsigned j = 0; j < 16; ++j) { const unsigned c = xb_ld(&bar[XB_XCNT(j)]); sum += c; cnt += (c > 0u) ? 1u : 0u; mine = (j == x) ? c : mine; even &= (c == (j < 8u ? G / 8u : 0u)) ? 1u : 0u; }
        if (sum == G) break;
        __builtin_amdgcn_s_sleep(1);
        if ((++sp & 255u) == 0u) { if (xb_ld(&bar[XB_TMO])) break; if (sp > XB_SPIN_CAP) { atomicAdd(&bar[XB_TMO], 1u); break; } }
    }
    nloc = mine > 0u ? mine : 1u; nx = cnt > 0u ? cnt : 1u;
    if (even && G == 256u && (G & 7u) == 0u && xb_ld(&bar[XB_MISMAP]) == 0u && xb_ld(&bar[XB_TMO]) == 0u) nx |= 0x10000u;
}
__device__ __forceinline__ void xcd_barrier(const XcdBarrier& b) {
    asm volatile("s_waitcnt vmcnt(0)" ::: "memory");
    __syncthreads();
    if (threadIdx.x == 0) {
        unsigned* bar = b.bar;
        __builtin_amdgcn_s_waitcnt(0);
        unsigned nloc = b.st[0], nx = b.st[1];
        if (nloc == 0u) { xcd_barrier_complete(bar, b.x, nloc, nx); b.st[0] = nloc; b.st[1] = nx; }
        nx &= 0xffffu;
        const unsigned old = xb_add(&bar[XB_XSUB(b.x)], 1u);
        const unsigned gen = old / nloc;
        if (old + 1u == (gen + 1u) * nloc) {
            __builtin_amdgcn_fence(__ATOMIC_RELEASE, "agent");
            asm volatile("s_waitcnt vmcnt(0)" ::: "memory");
            const unsigned og = xb_add(&bar[XB_TOP], 1u);
            const unsigned tg = og / nx;
            if (og + 1u == (tg + 1u) * nx) xb_add(&bar[XB_TOPGEN], 1u);
            else XB_SPIN(xb_ld(&bar[XB_TOPGEN]) == tg, bar);
            __builtin_amdgcn_fence(__ATOMIC_ACQUIRE, "agent");
            xb_add(&bar[XB_XGEN(b.x)], 1u);
            asm volatile("s_waitcnt vmcnt(0)" ::: "memory");
        } else {
            XB_SPIN(xb_ld(&bar[XB_XGEN(b.x)]) == gen, bar);
            __builtin_amdgcn_fence(__ATOMIC_ACQUIRE, "agent");
            asm volatile("s_waitcnt vmcnt(0)" ::: "memory");
        }
    }
    __syncthreads();
}

struct Args {
    const float *x, *g_mix, *w_in, *conv_w, *b_f, *w_conv_o, *w_attn_o, *w_out, *g_ffn, *w_router, *b_router, *w_gate_up, *b_gate_up, *w_down, *b_down, *g_final;
    float* out; unsigned char* ws; int ph_lo, ph_hi, li, pad;
};
struct Frame {
    LAS unsigned char* lds;
    int tid, lane, wave, vcu, G, bx;
};
__device__ __forceinline__ float wave_sum(float v) {
#pragma unroll
    for (int o = 1; o < 64; o <<= 1) v += __shfl_xor(v, o);
    return v;
}

struct SchedGrid {
    pg8::GridOrder o; unsigned A, B, atile, btile; int i0 = 0, i1 = 1 << 30;
    __device__ __forceinline__ bool next(int i, pg8::Unit& u) const { int pm, pn; if (i + i0 >= i1 || !o.map(i + i0, pm, pn)) return false;
        u.A = A + (unsigned)pm * atile; u.B = B + (unsigned)pn * btile; u.rows = 0u; u.pm = pm; u.pn = pn; u.e = 0; u.nvalid = 256; u.lrows = 0; return true; }
};
struct SchedMix {
    pg8::GridOrder o; unsigned A, B, atile, btile;
    __device__ __forceinline__ bool next(int i, pg8::Unit& u) const { int pm, pn; if (!o.map(i >> 1, pm, pn)) return false; const int hf = i & 1;
        u.A = A + (unsigned)pm * atile + hf * 1024u; u.B = B + (unsigned)pn * btile + hf * 1024u; u.rows = 0u; u.pm = pm; u.pn = pn; u.e = hf; u.nvalid = 256; u.lrows = 0; return true; }
};
struct SchedMoe {
    const LAS int* tab; int G, c, nct, gather; unsigned A, B, list, bexp, atile, btile;
    __device__ __forceinline__ bool next(int i, pg8::Unit& u) const {
        const int total = __builtin_amdgcn_readfirstlane(tab[32]); const long L = (long)i * G + c; if (L >= total) return false;
        int wgid = (int)L; { const int q = total / 8, r = total % 8, xcd = wgid % 8, off = wgid / 8; wgid = (xcd < r ? xcd * (q + 1) : r * (q + 1) + (xcd - r) * q) + off; }
        int tl_ = threadIdx.x; asm volatile("" : "+v"(tl_));
        const int ub1 = tab[(tl_ & 31) + 1];
        const unsigned long long mk = __ballot(wgid < ub1);
        const int e = __builtin_amdgcn_readfirstlane((int)__builtin_ctzll(mk)) & 31;
        const int l = wgid - __builtin_amdgcn_readfirstlane(tab[e]), nM = __builtin_amdgcn_readfirstlane(tab[64 + e]), pt = __builtin_amdgcn_readfirstlane(tab[96 + e]), cnt = __builtin_amdgcn_readfirstlane(tab[128 + e]);
        const int nig = 8 * nct, gid = l / nig, fm = gid * 8, gsz = (nM - fm) < 8 ? (nM - fm) : 8;
        const int rt = fm + ((l % nig) % gsz), ct = (l % nig) / gsz;
        u.e = e; u.pm = pt + rt; u.pn = ct; u.lrows = 0;
        u.B = B + (unsigned)e * bexp + (unsigned)ct * btile;
        if (gather) { u.A = A; u.rows = list + (unsigned)(e * LISTCAP + rt * 256) * 8u; const int nv = cnt - rt * 256; u.nvalid = nv < 256 ? nv : 256; }
        else { u.A = A + (unsigned)(pt + rt) * atile; u.rows = 0u; u.nvalid = 256; }
        return true;
    }
};

using pg8::f32x2; using pg8::u32x4; using pg8::cvt_pk_bf16; using pg8::bf_lo; using pg8::bf_hi;
__device__ __forceinline__ u32x4 pack8(const f32x4 a, const f32x4 b) { u32x4 w; w.x = cvt_pk_bf16(a[0], a[1]); w.y = cvt_pk_bf16(a[2], a[3]); w.z = cvt_pk_bf16(b[0], b[1]); w.w = cvt_pk_bf16(b[2], b[3]); return w; }
__device__ __forceinline__ float fast_exp(float x) { return __builtin_amdgcn_exp2f(x * 1.4426950408889634f); }
__device__ __forceinline__ unsigned pk4_fp8(float a, float b, float c, float d) { int w = __builtin_amdgcn_cvt_pk_fp8_f32(a, b, 0, false); w = __builtin_amdgcn_cvt_pk_fp8_f32(c, d, w, true); return (unsigned)w; }

#define EPI_COORDS() int tid_ = threadIdx.x; asm volatile("" : "+v"(tid_)); const int lane_ = tid_ & 63, wid_ = __builtin_amdgcn_readfirstlane(tid_ >> 6); \
    const int wr = wid_ >> 2, wc = wid_ & 3, fr = lane_ & 15, fq = lane_ >> 4
struct EpiG1 {
    static constexpr bool PERM = true; static constexpr bool BIAS_LDS = false;
    unsigned char* ws; float qscale;
    __device__ __forceinline__ bool operator()(f32x4 (&acc)[2][2][4][2], const pg8::Unit& u) const {
        EPI_COORDS();
        const int row0 = u.pm * 256 + wr * 64 + fr, cl = wc * 32 + 8 * fq, pn = u.pn;
        if (pn < 2 || (pn >= 6 && pn < 12)) {
            size_t boff; int colt; float sc = 1.f;
            if (pn < 2) { boff = WS_CB; colt = pn * 256; }
            else { const int t = (pn - 6) >> 1; boff = WS_Q + (size_t)t * (WS_K - WS_Q); colt = ((pn - 6) & 1) * 256; if (t == 0) sc = qscale; }
            bf16* base = (bf16*)(ws + boff);
#pragma unroll
            for (int ai = 0; ai < 2; ++ai)
#pragma unroll
                for (int m = 0; m < 4; ++m) { bf16* rowp = base + (size_t)(row0 + ai * 128 + m * 16) * 512 + colt + cl;
#pragma unroll
                    for (int bj = 0; bj < 2; ++bj) *(u32x4*)(rowp + bj * 128) = pack8(acc[ai][bj][m][0] * sc, acc[ai][bj][m][1] * sc); }
        } else {
            const int T = pn - 2; bf16* UC = (bf16*)(ws + WS_UC);
#pragma unroll
            for (int ai = 0; ai < 2; ++ai)
#pragma unroll
                for (int m = 0; m < 4; ++m) { bf16* rowp = UC + (size_t)(row0 + ai * 128 + m * 16) * 512 + T * 128 + cl;
                    *(u32x4*)rowp = pack8(acc[ai][0][m][0] * acc[ai][1][m][0], acc[ai][0][m][1] * acc[ai][1][m][1]); }
        }
        return false;
    }
};
struct EpiGate {
    static constexpr bool PERM = true; static constexpr bool BIAS_LDS = false;
    unsigned char* ws;
    __device__ __forceinline__ bool operator()(f32x4 (&acc)[2][2][4][2], const pg8::Unit& u) const {
        EPI_COORDS();
        const int row0 = u.pm * 256 + wr * 64 + fr, col0 = u.pn * 128 + wc * 32 + 8 * fq;
        unsigned char* G8 = ws + WS_G8;
#pragma unroll
        for (int bj = 0; bj < 2; ++bj) {
#pragma unroll
            for (int ai = 0; ai < 2; ++ai)
#pragma unroll
                for (int m = 0; m < 4; ++m) { f32x4 a0 = acc[ai][bj][m][0], a1 = acc[ai][bj][m][1];
#pragma unroll
                    for (int j = 0; j < 4; ++j) { a0[j] = __builtin_amdgcn_fmed3f(a0[j], -160.f, 160.f); a1[j] = __builtin_amdgcn_fmed3f(a1[j], -160.f, 160.f); }
                    v2u w8; w8.x = pk4_fp8(a0[0], a0[1], a0[2], a0[3]); w8.y = pk4_fp8(a1[0], a1[1], a1[2], a1[3]);
                    *(v2u*)(G8 + (size_t)(row0 + ai * 128 + m * 16) * 2048 + col0 + bj * 1024) = w8; }
            __builtin_amdgcn_sched_barrier(0);
        }
        return false;
    }
};
struct EpiMix {
    static constexpr bool PERM = true; static constexpr bool BIAS_LDS = false;
    const unsigned char* G8; bf16* MIX;
    __device__ __forceinline__ bool operator()(f32x4 (&acc)[2][2][4][2], const pg8::Unit& u) const {
        EPI_COORDS();
        const int row0 = u.pm * 256 + wr * 64 + fr, col0 = u.pn * 256 + wc * 32 + 8 * fq;
        const bool first = (u.e == 0);
        constexpr float KE = -0.25f * 1.4426950408889634f;
#define EM_DEC(w, lo4, hi4) do { const f32x2 a_ = __builtin_amdgcn_cvt_pk_f32_fp8((int)(w).x, false), b_ = __builtin_amdgcn_cvt_pk_f32_fp8((int)(w).x, true), \
            c_ = __builtin_amdgcn_cvt_pk_f32_fp8((int)(w).y, false), d_ = __builtin_amdgcn_cvt_pk_f32_fp8((int)(w).y, true); \
            lo4 = (f32x4){a_[0], a_[1], b_[0], b_[1]}; hi4 = (f32x4){c_[0], c_[1], d_[0], d_[1]}; } while (0)
#define EM_EXP(v) do { v = v * KE; _Pragma("unroll") for (int j = 0; j < 4; ++j) v[j] = __builtin_amdgcn_exp2f(v[j]); v = v + 1.0f; } while (0)
#define EM_RCP(v) do { _Pragma("unroll") for (int j = 0; j < 4; ++j) v[j] = __builtin_amdgcn_rcpf(v[j]); } while (0)
#pragma unroll
        for (int ai = 0; ai < 2; ++ai) {
            v2u ga[4][2], gc[4][2];
#pragma unroll
            for (int m = 0; m < 4; ++m)
#pragma unroll
                for (int bj = 0; bj < 2; ++bj) { const unsigned char* gp = G8 + (size_t)(row0 + ai * 128 + m * 16) * 2048 + col0 + bj * 128;
                    if (first) { gc[m][bj] = __builtin_nontemporal_load((const v2u*)gp); ga[m][bj] = *(const v2u*)(gp + 1024); }
                    else ga[m][bj] = __builtin_nontemporal_load((const v2u*)(gp + 1024)); }
            __builtin_amdgcn_sched_barrier(0);
            if (first) {
#pragma unroll
                for (int m = 0; m < 4; ++m)
#pragma unroll
                    for (int bj = 0; bj < 2; ++bj) { f32x4 a0, a1, c0, c1; EM_DEC(ga[m][bj], a0, a1); EM_DEC(gc[m][bj], c0, c1);
                        EM_EXP(a0); EM_EXP(a1); EM_EXP(c0); EM_EXP(c1); EM_RCP(c0); EM_RCP(c1);
                        acc[ai][bj][m][0] *= a0 * c0; acc[ai][bj][m][1] *= a1 * c1; __builtin_amdgcn_sched_barrier(0); }
            } else {
#pragma unroll
                for (int m = 0; m < 4; ++m) { const size_t off = (size_t)(row0 + ai * 128 + m * 16) * 1024 + col0;
#pragma unroll
                    for (int bj = 0; bj < 2; ++bj) { f32x4 a0, a1; EM_DEC(ga[m][bj], a0, a1); EM_EXP(a0); EM_EXP(a1); EM_RCP(a0); EM_RCP(a1);
                        *(u32x4*)(MIX + off + bj * 128) = pack8(acc[ai][bj][m][0] * a0, acc[ai][bj][m][1] * a1); __builtin_amdgcn_sched_barrier(0); } }
            }
            __builtin_amdgcn_sched_barrier(0);
        }
#undef EM_DEC
#undef EM_EXP
#undef EM_RCP
        return first;
    }
};
struct EpiOut {
    static constexpr bool PERM = true; static constexpr bool BIAS_LDS = false;
    const float* X; bf16* O;
    __device__ __forceinline__ bool operator()(f32x4 (&acc)[2][2][4][2], const pg8::Unit& u) const {
        EPI_COORDS();
        const int row0 = u.pm * 256 + wr * 64 + fr, col0 = u.pn * 256 + wc * 32 + 8 * fq;
        f32x4 xa[2][2][2], xb[2][2][2];
#define EO_LOAD(buf, q) do { _Pragma("unroll") for (int mm = 0; mm < 2; ++mm) _Pragma("unroll") for (int bj = 0; bj < 2; ++bj) { \
            const float* xp_ = X + (size_t)(row0 + ((q) >> 1) * 128 + (((q) & 1) * 2 + mm) * 16) * 1024 + col0 + bj * 128; \
            buf[mm][bj][0] = __builtin_nontemporal_load((const f32x4*)xp_); buf[mm][bj][1] = __builtin_nontemporal_load((const f32x4*)(xp_ + 4)); } } while (0)
#define EO_USE(buf, q) do { _Pragma("unroll") for (int mm = 0; mm < 2; ++mm) { const int ai_ = (q) >> 1, m_ = ((q) & 1) * 2 + mm; const size_t off_ = (size_t)(row0 + ai_ * 128 + m_ * 16) * 1024 + col0; \
            _Pragma("unroll") for (int bj = 0; bj < 2; ++bj) *(u32x4*)(O + off_ + bj * 128) = pack8(buf[mm][bj][0] + acc[ai_][bj][m_][0], buf[mm][bj][1] + acc[ai_][bj][m_][1]); } } while (0)
        EO_LOAD(xa, 0); EO_LOAD(xb, 1); __builtin_amdgcn_sched_barrier(0);
        EO_USE(xa, 0); __builtin_amdgcn_sched_barrier(0); EO_LOAD(xa, 2); __builtin_amdgcn_sched_barrier(0);
        EO_USE(xb, 1); __builtin_amdgcn_sched_barrier(0); EO_LOAD(xb, 3); __builtin_amdgcn_sched_barrier(0);
        EO_USE(xa, 2); __builtin_amdgcn_sched_barrier(0);
        EO_USE(xb, 3); __builtin_amdgcn_sched_barrier(0);
#undef EO_LOAD
#undef EO_USE
        return false;
    }
};
struct EpiSwiglu {
    static constexpr bool PERM = true; static constexpr bool BIAS_LDS = true;
    const float* bgu; unsigned char* ACT; const LAS unsigned char* gaux; LAS unsigned char* baux;
    __device__ __forceinline__ void bias_dma(const pg8::Unit& u, int par, int tid, int wid) const {
        const int i = tid & 255;
        const float* src = bgu + (size_t)u.e * 2048 + u.pn * 128 + (i < 128 ? i : 1024 + (i - 128));
        __builtin_amdgcn_global_load_lds((const unsigned*)src, (LAS unsigned*)(baux + par * 1024 + (wid & 3) * 256), 4, 0, 0);
    }
    __device__ __forceinline__ bool operator()(f32x4 (&acc)[2][2][4][2], const pg8::Unit& u) const {
        EPI_COORDS();
        const int row0 = u.pm * 256 + wr * 64 + fr, ch0 = u.pn * 128 + wc * 32 + 8 * fq;
        float rs[2][4];
#pragma unroll
        for (int ai = 0; ai < 2; ++ai)
#pragma unroll
            for (int m = 0; m < 4; ++m) { const int r = ai * 128 + wr * 64 + m * 16 + fr; rs[ai][m] = ((const LAS float*)(gaux + u.lrows))[2 * (r < u.nvalid ? r : 0) + 1]; }
        const LAS float* bp = (const LAS float*)(baux + (u.lrows >> 1)) + wc * 32 + 8 * fq;
        f32x4 bg[2], bl1[2];
#pragma unroll
        for (int n = 0; n < 2; ++n) { bg[n] = *(const LAS f32x4*)(bp + 4 * n); bl1[n] = *(const LAS f32x4*)(bp + 128 + 4 * n) + 1.0f; }
        constexpr float CE = -1.702f * 1.4426950408889634f;
#pragma unroll
        for (int ai = 0; ai < 2; ++ai)
#pragma unroll
            for (int m = 0; m < 4; ++m) { f32x4 av[2]; const float r1 = rs[ai][m];
#pragma unroll
                for (int n = 0; n < 2; ++n) { f32x4 g = acc[ai][0][m][n] * r1 + bg[n], l = acc[ai][1][m][n] * r1 + bl1[n];
#pragma unroll
                    for (int j = 0; j < 4; ++j) { g[j] = fminf(g[j], 7.0f); l[j] = __builtin_amdgcn_fmed3f(l[j], -6.0f, 8.0f); }
                    f32x4 t = g * CE;
#pragma unroll
                    for (int j = 0; j < 4; ++j) t[j] = __builtin_amdgcn_exp2f(t[j]);
                    t = t * 0.25f + 0.25f;
#pragma unroll
                    for (int j = 0; j < 4; ++j) t[j] = __builtin_amdgcn_rcpf(t[j]);
                    av[n] = (g * t) * l; }
                v2u w8; w8.x = pk4_fp8(av[0][0], av[0][1], av[0][2], av[0][3]); w8.y = pk4_fp8(av[1][0], av[1][1], av[1][2], av[1][3]);
                *(v2u*)(ACT + (size_t)(row0 + ai * 128 + m * 16) * 1024 + ch0) = w8; }
        return false;
    }
};
struct EpiDown {
    static constexpr bool PERM = true; static constexpr bool BIAS_LDS = true;
    const float* bd; unsigned char* Y; LAS unsigned char* baux;
    __device__ __forceinline__ void bias_dma(const pg8::Unit& u, int par, int tid, int wid) const {
        __builtin_amdgcn_global_load_lds((const unsigned*)(bd + (size_t)u.e * 1024 + u.pn * 256 + (tid & 255)), (LAS unsigned*)(baux + par * 1024 + (wid & 3) * 256), 4, 0, 0);
    }
    __device__ __forceinline__ bool operator()(f32x4 (&acc)[2][2][4][2], const pg8::Unit& u) const {
        EPI_COORDS();
        const int row0 = u.pm * 256 + wr * 64 + fr, col0 = u.pn * 256 + wc * 32 + 8 * fq;
        const LAS float* bp = (const LAS float*)(baux + (u.lrows >> 1)) + wc * 32 + 8 * fq;
#pragma unroll
        for (int bj = 0; bj < 2; ++bj) {
            const f32x4 b0 = *(const LAS f32x4*)(bp + bj * 128) * 16.f, b1 = *(const LAS f32x4*)(bp + bj * 128 + 4) * 16.f;
#pragma unroll
            for (int ai = 0; ai < 2; ++ai)
#pragma unroll
                for (int m = 0; m < 4; ++m) { const f32x4 a0 = acc[ai][bj][m][0] + b0, a1 = acc[ai][bj][m][1] + b1;
                    v2u w8; w8.x = pk4_fp8(a0[0], a0[1], a0[2], a0[3]); w8.y = pk4_fp8(a1[0], a1[1], a1[2], a1[3]);
                    *(v2u*)(Y + (size_t)(row0 + ai * 128 + m * 16) * 1024 + col0 + bj * 128) = w8; }
            __builtin_amdgcn_sched_barrier(0);
        }
        return false;
    }
};

__device__ __forceinline__ void p0_transpose_item(const float* W, int ldw, int k0, int n0s, bf16* WT, size_t drow0, int ldk, int kd0, LAS float* scr, int lane) {
#pragma unroll 8
    for (int i = 0; i < 32; ++i) { const int kk = 2 * i + (lane >> 5); scr[kk * 33 + (lane & 31)] = W[(size_t)(k0 + kk) * ldw + n0s + (lane & 31)]; }
    LDS_WAIT(); asm volatile("" ::: "memory");
    const int c = lane & 7;
#pragma unroll
    for (int j = 0; j < 4; ++j) { const int n = (lane >> 3) + 8 * j; const LAS float* s = scr + (8 * c) * 33 + n;
        v4u o; o.x = pk2(s[0 * 33], s[1 * 33]); o.y = pk2(s[2 * 33], s[3 * 33]); o.z = pk2(s[4 * 33], s[5 * 33]); o.w = pk2(s[6 * 33], s[7 * 33]);
        *(GAS v4u*)(WT + (drow0 + n) * (size_t)ldk + kd0 + 8 * c) = o; }
    LDS_WAIT(); asm volatile("" ::: "memory");
}
__device__ __forceinline__ void p0_item8_load(f32x4 (&v)[4][4], const float* W, int ldw, int k0, int n0s, int lane) {
    const int ng = lane & 7, kg0 = lane >> 3;
#pragma unroll
    for (int b = 0; b < 4; ++b)
#pragma unroll
        for (int r = 0; r < 4; ++r) v[b][r] = __builtin_nontemporal_load((const GAS f32x4*)(W + (size_t)(k0 + 4 * (kg0 + 8 * b) + r) * ldw + n0s + 4 * ng));
}
__device__ __forceinline__ void p0_item8_finish(const f32x4 (&v)[4][4], int k0, unsigned char* WT, size_t drow0, int ldk, int kd0, float scale, const float* kscale, LAS float* scrf, int lane) {
    LAS unsigned char* scr = (LAS unsigned char*)scrf;
    const int ng = lane & 7, kg0 = lane >> 3;
#pragma unroll
    for (int b = 0; b < 4; ++b) { const int kk = 4 * (kg0 + 8 * b);
        float ks[4];
#pragma unroll
        for (int r = 0; r < 4; ++r) ks[r] = kscale ? scale * kscale[k0 + kk + r] : scale;
#pragma unroll
        for (int c = 0; c < 4; ++c) *(LAS unsigned*)(scr + (4 * ng + c) * 144 + kk) = pk4_fp8(v[b][0][c] * ks[0], v[b][1][c] * ks[1], v[b][2][c] * ks[2], v[b][3][c] * ks[3]); }
    LDS_WAIT(); asm volatile("" ::: "memory");
    const int ch = lane & 7;
#pragma unroll
    for (int j = 0; j < 4; ++j) { const int n = (lane >> 3) + 8 * j; const v4u o = *(const LAS v4u*)(scr + n * 144 + 16 * ch);
        *(GAS v4u*)(WT + (drow0 + n) * (size_t)ldk + kd0 + 16 * ch) = o; }
    LDS_WAIT(); asm volatile("" ::: "memory");
}
__device__ __forceinline__ void p0_transpose_item8(const float* W, int ldw, int k0, int n0s, unsigned char* WT, size_t drow0, int ldk, int kd0, float scale, const float* kscale, LAS float* scrf, int lane) {
    f32x4 v[4][4]; p0_item8_load(v, W, ldw, k0, n0s, lane); p0_item8_finish(v, k0, WT, drow0, ldk, kd0, scale, kscale, scrf, lane);
}
__device__ __forceinline__ int win_src_col(int vb) {
    const int v = vb * 32;
    if (v < 512) return v;
    if (v < 1536) { const int T = (v - 512) >> 8, j = (v - 512) & 255; return j < 128 ? 512 + 128 * T + j : 1024 + 128 * T + (j - 128); }
    if (v < 3072) return v;
    { const int T = (v - 3072) >> 8, j = (v - 3072) & 255; return j < 128 ? 3080 + 128 * T + j : 4104 + 128 * T + (j - 128); }
}
__device__ __forceinline__ int wgu_src_col(int vb) { const int T = vb >> 3, j = (vb & 7) * 32; return j < 128 ? 128 * T + j : 1024 + 128 * T + (j - 128); }

struct ConvItem { const float* W; unsigned char* WT; const float* ks; int ldw, k0, n0s; size_t drow0; };
__device__ __forceinline__ ConvItem conv_item(const Args& a, int r) {
    unsigned char* ws = a.ws; ConvItem c; constexpr int I_GU = 32 * 8 * 64;
    if (r < I_GU) { const int e = r / 512, q = r % 512, kb = q / 64, vb = q % 64; c.W = a.w_gate_up + (size_t)e * 1024 * 2048; c.ldw = 2048; c.k0 = 128 * kb; c.n0s = wgu_src_col(vb); c.WT = ws + WS_WGU; c.drow0 = (size_t)e * 2048 + vb * 32; c.ks = a.g_ffn; }
    else { r -= I_GU; const int e = r / 256, q = r % 256, kb = q / 32, nb = q % 32; c.W = a.w_down + (size_t)e * 1024 * 1024; c.ldw = 1024; c.k0 = 128 * kb; c.n0s = 32 * nb; c.WT = ws + WS_WD; c.drow0 = (size_t)e * 1024 + nb * 32; c.ks = nullptr; }
    return c;
}
__device__ __forceinline__ void cvt_chunk(const Frame& F, const Args& a, int chunk) {
    LAS float* scr = (LAS float*)(F.lds + RING_OFF + F.wave * 16384);
    const ConvItem c = conv_item(a, chunk * 8 + F.wave);
    p0_transpose_item8(c.W, c.ldw, c.k0, c.n0s, c.WT, c.drow0, 1024, c.k0, 64.f, c.ks, scr, F.lane);
}
__device__ __forceinline__ void cvt_drain(const Frame& F, const Args& a, int upto) {
    volatile LAS unsigned* st = (volatile LAS unsigned*)(F.lds + MISC_OFF) + 8;
    unsigned* cnt = (unsigned*)(a.ws + WS_CTL) + CW_CVT;
    __syncthreads();
    for (unsigned p = 0;; p ^= 1u) {
        if (F.tid == 0) st[6 + p] = xb_add(cnt, 1u);
        __syncthreads();
        const unsigned ch = st[6 + p];
        if (ch < (unsigned)CVT_NCH) cvt_chunk(F, a, (int)ch);
        if (ch >= (unsigned)upto) break;
    }
    __syncthreads();
}
__device__ __forceinline__ void xcd_barrier_fill(const XcdBarrier& b, const Frame& F, const Args& a, const bool want_local = false) {
    asm volatile("s_waitcnt vmcnt(0)" ::: "memory");
    __syncthreads();
    volatile LAS unsigned* st = b.st;
    unsigned* bar = b.bar;
    if (F.tid == 0) {
        __builtin_amdgcn_s_waitcnt(0);
        unsigned nloc = st[0], nx = st[1];
        if (nloc == 0u) { xcd_barrier_complete(bar, b.x, nloc, nx); st[0] = nloc; st[1] = nx; }
        const bool local = want_local && (nx & 0x10000u) != 0u;
        nx &= 0xffffu;
        const unsigned old = xb_add(&bar[XB_XSUB(b.x)], 1u);
        const unsigned gen = old / nloc;
        if (old + 1u == (gen + 1u) * nloc) {
            if (!local) {
            __builtin_amdgcn_fence(__ATOMIC_RELEASE, "agent");
            asm volatile("s_waitcnt vmcnt(0)" ::: "memory");
            const unsigned og = xb_add(&bar[XB_TOP], 1u);
            const unsigned tg = og / nx;
            if (og + 1u == (tg + 1u) * nx) xb_add(&bar[XB_TOPGEN], 1u);
            else XB_SPIN(xb_ld(&bar[XB_TOPGEN]) == tg, bar);
            }
            xb_add(&bar[XB_XGEN(b.x)], 1u);
            __builtin_amdgcn_fence(__ATOMIC_ACQUIRE, "agent");
            asm volatile("s_waitcnt vmcnt(0)" ::: "memory");
            st[2] = 0xffffffffu;
        } else st[2] = gen;
    }
    __syncthreads();
    const unsigned gen = st[2];
    if (gen != 0xffffffffu) {
        unsigned* cnt = (unsigned*)(a.ws + WS_CTL) + CW_CVT;
        unsigned sp = 0u, exh = 0u;
        const unsigned nloc = st[0];
        for (unsigned p = 0;; p ^= 2u) {
            if (F.tid == 0) {
                const unsigned arr = xb_ld(&bar[XB_XSUB(b.x)]) - gen * nloc;
                unsigned done = (xb_ld(&bar[XB_XGEN(b.x)]) != gen) ? 1u : 0u, ch = 0xffffffffu;
                if (!done) {
                    if (!exh && arr + CVT_STOP < nloc) { ch = xb_add(cnt, 1u); if (ch >= (unsigned)CVT_NCH) { ch = 0xffffffffu; exh = 1u; } }
                    if (ch == 0xffffffffu) { __builtin_amdgcn_s_sleep(1);
                        if ((++sp & 255u) == 0u) { if (xb_ld(&bar[XB_TMO])) done = 1u; else if (sp > XB_SPIN_CAP) { atomicAdd(&bar[XB_TMO], 1u); done = 1u; } } }
                }
                st[3 + p] = done; st[4 + p] = ch;
            }
            __syncthreads();
            const unsigned done = st[3 + p], ch = st[4 + p];
            if (done) break;
            if (ch != 0xffffffffu) cvt_chunk(F, a, (int)ch);
        }
        if (F.tid == 0) { __builtin_amdgcn_fence(__ATOMIC_ACQUIRE, "agent"); asm volatile("s_waitcnt vmcnt(0)" ::: "memory"); }
    }
    __syncthreads();
}
__device__ __forceinline__ void p0_prologue(const Frame& F, const Args& a) {
    unsigned char* ws = a.ws;
    bf16* Win_t = (bf16*)(ws + WS_WIN); bf16* W3_t = (bf16*)(ws + WS_W3); bf16* Wout_t = (bf16*)(ws + WS_WOUT);
    LAS float* scr = (LAS float*)(F.lds + RING_OFF + F.wave * 16384);
    const int gw = F.vcu * 8 + F.wave, NGW = F.G * 8;
    constexpr int I_IN = 16 * 96  , I_G8 = 8 * 64  , I_CO = 8 * 32, I_AO = 8 * 32, I_OUT = 16 * 32;
    constexpr int NITEMS = I_G8 + I_IN + I_CO + I_AO + I_OUT;
    for (int it = gw; it < NITEMS; it += NGW) {
        int r = it;
        if (r < I_G8) { const int kb = r / 64, vb = 96 + r % 64;
            p0_transpose_item8(a.w_in, INCOLS, 128 * kb, win_src_col(vb), ws + WS_WG8, (size_t)(vb - 96) * 32, 1024, 128 * kb, 64.f, nullptr, scr, F.lane); continue; } r -= I_G8;
        if (r < I_IN) { const int kb = r / 96, vb = r % 96; p0_transpose_item(a.w_in, INCOLS, 64 * kb, win_src_col(vb), Win_t, (size_t)vb * 32, 1024, 64 * kb, scr, F.lane); continue; } r -= I_IN;
        if (r < I_CO) { const int kb = r / 32, nb = r % 32; p0_transpose_item(a.w_conv_o, 1024, 64 * kb, 32 * nb, W3_t, (size_t)nb * 32, 1024, 64 * kb, scr, F.lane); continue; } r -= I_CO;
        if (r < I_AO) { const int kb = r / 32, nb = r % 32; p0_transpose_item(a.w_attn_o, 1024, 64 * kb, 32 * nb, W3_t, (size_t)nb * 32, 1024, 512 + 64 * kb, scr, F.lane); continue; } r -= I_AO;
        { const int kb = r / 32, nb = r % 32; p0_transpose_item(a.w_out, 1024, 64 * kb, 32 * nb, Wout_t, (size_t)nb * 32, 1024, 64 * kb, scr, F.lane); }
    }
    __syncthreads();
    LAS float* wf = (LAS float*)(F.lds + RING_OFF);
    for (int i = F.tid; i < 8 * 1024; i += 512) { const int c = i & 7, k = i >> 3; wf[c * 1024 + k] = a.w_in[(size_t)k * INCOLS + 3072 + c]; }
    __syncthreads();
    bf16* Hb = (bf16*)(ws + WS_H); float* LOGF = (float*)(ws + WS_LOGF);
    f32x4 gv[4];
#pragma unroll
    for (int j = 0; j < 4; ++j) gv[j] = ((const GAS f32x4*)a.g_mix)[F.lane + 64 * j];
    const float bfl = a.b_f[F.lane & 7];
    f32x4 xn[2][4];
#pragma unroll
    for (int q = 0; q < 2; ++q) { const int mq = gw + q * NGW; const GAS f32x4* xr = (const GAS f32x4*)(a.x + (size_t)(mq < NTOK ? mq : gw) * 1024) + F.lane;
#pragma unroll
        for (int j = 0; j < 4; ++j) xn[q][j] = __builtin_nontemporal_load(xr + 64 * j); }
    int par = 0;
    for (int m = gw; m < NTOK; m += NGW, par ^= 1) {
        f32x4 v[4]; float s = 0.f;
        { const int mq = m + 2 * NGW; const GAS f32x4* xr = (const GAS f32x4*)(a.x + (size_t)(mq < NTOK ? mq : gw) * 1024) + F.lane;
          if (par == 0) {
#pragma unroll
            for (int j = 0; j < 4; ++j) { v[j] = xn[0][j]; xn[0][j] = __builtin_nontemporal_load(xr + 64 * j); } }
          else {
#pragma unroll
            for (int j = 0; j < 4; ++j) { v[j] = xn[1][j]; xn[1][j] = __builtin_nontemporal_load(xr + 64 * j); } } }
#pragma unroll
        for (int j = 0; j < 4; ++j) s += (v[j].x * v[j].x + v[j].y * v[j].y) + (v[j].z * v[j].z + v[j].w * v[j].w);
        const float rstd = 1.f / sqrtf(wave_sum(s) * (1.f / 1024.f) + RMS_EPS);
#pragma unroll
        for (int j = 0; j < 4; ++j) v[j] = (v[j] * rstd) * gv[j];
        GAS unsigned long long* o8 = (GAS unsigned long long*)(Hb + (size_t)m * 1024) + F.lane;
#pragma unroll
        for (int j = 0; j < 4; ++j) __builtin_nontemporal_store((unsigned long long)pk2(v[j].x, v[j].y) | ((unsigned long long)pk2(v[j].z, v[j].w) << 32), o8 + 64 * j);
        GAS unsigned* o4 = (GAS unsigned*)(ws + WS_H8 + (size_t)m * 1024) + F.lane;
#pragma unroll
        for (int j = 0; j < 4; ++j) __builtin_nontemporal_store(pk4_fp8(v[j].x * 16.f, v[j].y * 16.f, v[j].z * 16.f, v[j].w * 16.f), o4 + 64 * j);
        float p[8];
#pragma unroll
        for (int c = 0; c < 8; ++c) { float d = 0.f;
#pragma unroll
            for (int j = 0; j < 4; ++j) { const f32x4 w = ((const LAS f32x4*)(wf + c * 1024))[F.lane + 64 * j]; d += (v[j].x * w.x + v[j].y * w.y) + (v[j].z * w.z + v[j].w * w.w); }
            p[c] = d; }
#pragma unroll
        for (int c = 0; c < 4; ++c) { const bool up = (F.lane & 4) != 0; const float send = up ? p[c] : p[c + 4], keep = up ? p[c + 4] : p[c]; p[c] = keep + __shfl_xor(send, 4); }
#pragma unroll
        for (int c = 0; c < 2; ++c) { const bool up = (F.lane & 2) != 0; const float send = up ? p[c] : p[c + 2], keep = up ? p[c + 2] : p[c]; p[c] = keep + __shfl_xor(send, 2); }
        { const bool up = (F.lane & 1) != 0; const float send = up ? p[0] : p[1], keep = up ? p[1] : p[0]; p[0] = keep + __shfl_xor(send, 1); }
        float tot = p[0]; tot += __shfl_xor(tot, 8); tot += __shfl_xor(tot, 16); tot += __shfl_xor(tot, 32);
        if (F.lane < 8) { const float z = tot + bfl; LOGF[(size_t)m * 8 + F.lane] = fminf(z, 0.f) - log1pf(expf(-fabsf(z))); }
    }
}

__device__ __forceinline__ void p2_conv(const Frame& F, const Args& a) {
    unsigned char* ws = a.ws;
    const bf16* CB = (const bf16*)(ws + WS_CB); const bf16* UC = (const bf16*)(ws + WS_UC); bf16* A3 = (bf16*)(ws + WS_H);
    const int ch = F.lane * 8;
    float w0[8], w1[8], w2[8];
#pragma unroll
    for (int j = 0; j < 8; ++j) { w0[j] = a.conv_w[ch + j]; w1[j] = a.conv_w[512 + ch + j]; w2[j] = a.conv_w[1024 + ch + j]; }
    for (int panel = F.vcu; panel < NTOK / 256; panel += F.G) {
        const int r0 = panel * 256 + F.wave * 32;
        const GAS v4u* up = (const GAS v4u*)(UC + (size_t)r0 * 512 + ch); const GAS v4u* cp = (const GAS v4u*)(CB + (size_t)r0 * 512 + ch);
        v4u um2 = (v4u){0u, 0u, 0u, 0u}, um1 = um2;
        if ((r0 & (SEQLEN - 1)) != 0) { um2 = up[-128]; um1 = up[-64]; }
        v4u ub[2][8], cb[2][8];
#pragma unroll
        for (int j = 0; j < 8; ++j) { ub[0][j] = __builtin_nontemporal_load(up + 64 * j); cb[0][j] = __builtin_nontemporal_load(cp + 64 * j); }
#pragma unroll
        for (int b = 0; b < 4; ++b) {
            if (b < 3) {
#pragma unroll
                for (int j = 0; j < 8; ++j) { ub[(b + 1) & 1][j] = __builtin_nontemporal_load(up + 64 * (8 * (b + 1) + j)); cb[(b + 1) & 1][j] = __builtin_nontemporal_load(cp + 64 * (8 * (b + 1) + j)); }
            }
            __builtin_amdgcn_sched_barrier(0);
#pragma unroll
            for (int j = 0; j < 8; ++j) {
                const v4u u2 = ub[b & 1][j], c4 = cb[b & 1][j];
                const unsigned U0[4] = {um2.x, um2.y, um2.z, um2.w}, U1[4] = {um1.x, um1.y, um1.z, um1.w}, U2[4] = {u2.x, u2.y, u2.z, u2.w}, B[4] = {c4.x, c4.y, c4.z, c4.w};
                unsigned o[4];
#pragma unroll
                for (int q = 0; q < 4; ++q) {
                    const float lo = bf_lo(B[q]) * (w0[2 * q] * bf_lo(U0[q]) + w1[2 * q] * bf_lo(U1[q]) + w2[2 * q] * bf_lo(U2[q]));
                    const float hi = bf_hi(B[q]) * (w0[2 * q + 1] * bf_hi(U0[q]) + w1[2 * q + 1] * bf_hi(U1[q]) + w2[2 * q + 1] * bf_hi(U2[q]));
                    o[q] = pk2(lo, hi); }
                *(GAS v4u*)(A3 + (size_t)(r0 + 8 * b + j) * 1024 + ch) = (v4u){o[0], o[1], o[2], o[3]};
                um2 = um1; um1 = u2;
            }
            __builtin_amdgcn_sched_barrier(0);
        }
    }
}
__device__ __forceinline__ void p2_keybias(const Frame& F, const float* LOGF, int bh, LAS float* kb, LAS float* red) {
    const int b = bh >> 3, h = bh & 7;
    int tid = threadIdx.x; asm volatile("" : "+v"(tid));
    const int lane = tid & 63;
    const float* src = LOGF + ((size_t)b * SEQLEN) * 8 + h + (size_t)tid * 32;
    float v[4]; float s = 0.f;
#pragma unroll
    for (int j = 0; j < 4; ++j) { v[j] = src[j * 8]; s += v[j]; v[j] = s; }
    float ws_ = s;
#pragma unroll
    for (int o = 1; o < 64; o <<= 1) { const float t = __shfl_up(ws_, o); if (lane >= o) ws_ += t; }
    if (lane == 63) red[tid >> 6] = ws_;
    __syncthreads();
    float woff = 0.f;
    for (int w = 0; w < (tid >> 6); ++w) woff += red[w];
    const float base = woff + ws_ - s;
#pragma unroll
    for (int j = 0; j < 4; ++j) kb[tid * 4 + j] = -(base + v[j]) * 1.4426950408889634f;
    __syncthreads();
}

__device__ __forceinline__ unsigned bf16_rne_bits(float f) { unsigned u = __builtin_bit_cast(unsigned, f); return (u + 0x7fffu + ((u >> 16) & 1u)) & 0xffff0000u; }
__device__ __forceinline__ void p5_router(const Frame& F, const Args& a) {
    typedef short bf16x8 __attribute__((ext_vector_type(8)));
    unsigned char* ws = a.ws;
    const bf16* X1 = (const bf16*)(ws + WS_X1B); unsigned char* H2 = ws + WS_H2;
    unsigned* CNT = (unsigned*)(ws + WS_CTL) + CW_CNT; v2u* LIST = (v2u*)(ws + WS_LIST); unsigned* TOKSLOT = (unsigned*)(ws + WS_TOKSLOT); float* TOKW = (float*)(ws + WS_TOKW);
    LAS v4u* whi = (LAS v4u*)(F.lds + RING_OFF); LAS v4u* wlo = whi + 4096;
    for (int idx = F.tid; idx < 4096; idx += 512) { const int sidx = idx >> 7, eb = (idx >> 6) & 1, ln = idx & 63, c = ln & 15, q = ln >> 4;
        unsigned hb[8], lb[8];
#pragma unroll
        for (int j = 0; j < 8; ++j) { const int k = 32 * sidx + 8 * q + j; const float w = a.w_router[k * 32 + 16 * eb + c] * a.g_ffn[k];
            hb[j] = bf16_rne_bits(w); lb[j] = bf16_rne_bits(w - __uint_as_float(hb[j])); }
        whi[idx] = (v4u){(hb[0] >> 16) | hb[1], (hb[2] >> 16) | hb[3], (hb[4] >> 16) | hb[5], (hb[6] >> 16) | hb[7]};
        wlo[idx] = (v4u){(lb[0] >> 16) | lb[1], (lb[2] >> 16) | lb[3], (lb[4] >> 16) | lb[5], (lb[6] >> 16) | lb[7]}; }
    LAS int* hist = (LAS int*)(F.lds + P5_OFF); LAS int* basev = hist + 32; LAS unsigned* ent = (LAS unsigned*)(hist + 64);
    LAS float* rstd_l = (LAS float*)(F.lds + GAUX_OFF);
    const int fr = F.lane & 15, fq = F.lane >> 4;
    const float br0 = a.b_router[fr], br1 = a.b_router[16 + fr];
    __syncthreads();
    for (int chunk = F.vcu; chunk < NTOK / 256; chunk += F.G) {
        if (F.tid < 32) hist[F.tid] = 0;
        __syncthreads();
#pragma unroll 1
        for (int pass = 0; pass < 2; ++pass) {
            const int rl0 = pass * 128 + F.wave * 16;
            const bf16* xp = X1 + (size_t)(chunk * 256 + rl0 + fr) * 1024 + 8 * fq;
            unsigned char* hp = H2 + (size_t)(chunk * 256 + rl0 + fr) * 1024 + 8 * fq;
            f32x4 acc0 = (f32x4){0.f, 0.f, 0.f, 0.f}, acc1 = acc0; float ss = 0.f;
            v4u buf[8];
#pragma unroll
            for (int p = 0; p < 8; ++p) buf[p] = *(const GAS v4u*)(xp + 32 * p);
#pragma unroll 1
            for (int s0 = 0; s0 < 32; s0 += 8) {
#pragma unroll
                for (int p = 0; p < 8; ++p) { const int sidx = s0 + p;
                    const v4u xv = buf[p];
                    if (s0 + 8 < 32) buf[p] = *(const GAS v4u*)(xp + 32 * (sidx + 8));
                    const float xs[8] = {bf_lo(xv.x), bf_hi(xv.x), bf_lo(xv.y), bf_hi(xv.y), bf_lo(xv.z), bf_hi(xv.z), bf_lo(xv.w), bf_hi(xv.w)};
#pragma unroll
                    for (int j = 0; j < 8; ++j) ss += xs[j] * xs[j];
                    v2u h8; h8.x = pk4_fp8(xs[0] * 16.f, xs[1] * 16.f, xs[2] * 16.f, xs[3] * 16.f); h8.y = pk4_fp8(xs[4] * 16.f, xs[5] * 16.f, xs[6] * 16.f, xs[7] * 16.f);
                    *(GAS v2u*)(hp + 32 * sidx) = h8;
                    const bf16x8 ah = __builtin_bit_cast(bf16x8, xv);
                    const bf16x8 wh0 = __builtin_bit_cast(bf16x8, whi[(sidx * 2 + 0) * 64 + F.lane]), wh1 = __builtin_bit_cast(bf16x8, whi[(sidx * 2 + 1) * 64 + F.lane]);
                    const bf16x8 wl0 = __builtin_bit_cast(bf16x8, wlo[(sidx * 2 + 0) * 64 + F.lane]), wl1 = __builtin_bit_cast(bf16x8, wlo[(sidx * 2 + 1) * 64 + F.lane]);
                    acc0 = __builtin_amdgcn_mfma_f32_16x16x32_bf16(ah, wh0, acc0, 0, 0, 0); acc1 = __builtin_amdgcn_mfma_f32_16x16x32_bf16(ah, wh1, acc1, 0, 0, 0);
                    acc0 = __builtin_amdgcn_mfma_f32_16x16x32_bf16(ah, wl0, acc0, 0, 0, 0); acc1 = __builtin_amdgcn_mfma_f32_16x16x32_bf16(ah, wl1, acc1, 0, 0, 0); }
            }
            ss += __shfl_xor(ss, 16); ss += __shfl_xor(ss, 32);
            const float rstd = 1.f / sqrtf(ss * (1.f / 1024.f) + RMS_EPS);
            if (fq == 0) rstd_l[rl0 + fr] = rstd;
#pragma unroll
            for (int reg = 0; reg < 4; ++reg) {
                const float rsr = __shfl(rstd, 4 * fq + reg);
                float l0 = acc0[reg] * rsr + br0, l1 = acc1[reg] * rsr + br1;
                float tv[4]; int ti[4];
#pragma unroll
                for (int k = 0; k < 4; ++k) { float bv; int bi; if (l1 > l0) { bv = l1; bi = 16 + fr; } else { bv = l0; bi = fr; }
#pragma unroll
                    for (int o = 1; o < 16; o <<= 1) { const float ov = __shfl_xor(bv, o); const int oi = __shfl_xor(bi, o); if (ov > bv || (ov == bv && oi < bi)) { bv = ov; bi = oi; } }
                    tv[k] = bv; ti[k] = bi; if (bi == fr) l0 = -INFINITY; if (bi == 16 + fr) l1 = -INFINITY; }
                const float e1 = expf(tv[1] - tv[0]), e2 = expf(tv[2] - tv[0]), e3 = expf(tv[3] - tv[0]);
                const float inv = 1.f / (1.f + e1 + e2 + e3);
                if (fr < 4) { const int ek = fr == 0 ? ti[0] : (fr == 1 ? ti[1] : (fr == 2 ? ti[2] : ti[3]));
                    const float gk = (fr == 0 ? 1.f : (fr == 1 ? e1 : (fr == 2 ? e2 : e3))) * inv;
                    const int rl = rl0 + 4 * fq + reg;
                    const int pos = __hip_atomic_fetch_add(&hist[ek], 1, __ATOMIC_RELAXED, __HIP_MEMORY_SCOPE_WORKGROUP);
                    ent[rl * 4 + fr] = ((unsigned)ek << 16) | (unsigned)pos; TOKW[(size_t)(chunk * 256 + rl) * 4 + fr] = gk; }
            }
        }
        __syncthreads();
        if (F.tid < 32) { const int n = hist[F.tid]; basev[F.tid] = n ? (int)__hip_atomic_fetch_add(CNT + F.tid, (unsigned)n, RLX_AGENT) : 0; }
        __syncthreads();
        for (int i = F.tid; i < 1024; i += 512) { const unsigned en = ent[i]; const int e = (int)(en >> 16), pos = basev[e] + (int)(en & 0xffffu); const int rl = i >> 2, row = chunk * 256 + rl;
            LIST[(size_t)e * LISTCAP + pos] = (v2u){(unsigned)row, __float_as_uint(rstd_l[rl])}; TOKSLOT[(size_t)row * 4 + (i & 3)] = ((unsigned)e << 16) | (unsigned)pos; }
        __syncthreads();
    }
}
__device__ __forceinline__ void moe_table(const Frame& F, const Args& a, int nct) {
    LAS int* tab = (LAS int*)(F.lds + MOETAB_OFF);
    unsigned* CNT = (unsigned*)(a.ws + WS_CTL) + CW_CNT;
    __syncthreads();
    if (F.tid < 64) {
        const int e = F.lane;
        const int c = (e < 32) ? (int)__hip_atomic_load(CNT + (e & 31), RLX_AGENT) : 0;
        const int ntl = (c + 255) >> 8;
        int ps = ntl;
#pragma unroll
        for (int o = 1; o < 32; o <<= 1) { const int t = __shfl_up(ps, o); if (e >= o) ps += t; }
        const int pt = ps - ntl;
        if (e < 32) { tab[e] = pt * nct; tab[64 + e] = ntl; tab[96 + e] = pt; tab[128 + e] = c; }
        if (e == 31) tab[32] = ps * nct;
    }
    __syncthreads();
}
#define P8_SLOTS(S, W, mm) do { const int mc_ = (mm) < NTOK ? (mm) : gw; S = TOKSLOT[mc_]; W = TOKW[mc_]; } while (0)
#define P8_ISSUE(V, Y, S, mm) do { const int mc_ = (mm) < NTOK ? (mm) : gw; const GAS v2u* xr_ = (const GAS v2u*)(X1B + (size_t)mc_ * 1024) + F.lane; \
    _Pragma("unroll") for (int j = 0; j < 4; ++j) { const v2u xb_ = __builtin_nontemporal_load(xr_ + 64 * j); V[j] = (f32x4){bf_lo(xb_.x), bf_hi(xb_.x), bf_lo(xb_.y), bf_hi(xb_.y)}; } \
    const unsigned tsv_[4] = {S.x, S.y, S.z, S.w}; \
    _Pragma("unroll") for (int k = 0; k < 4; ++k) { const int e_ = (int)(tsv_[k] >> 16) & 31, pos_ = (int)(tsv_[k] & 0xffffu); const size_t slot_ = (size_t)tab[96 + e_] * 256 + pos_; \
        const GAS unsigned* yr_ = (const GAS unsigned*)(Y_ + slot_ * 1024) + F.lane; \
        _Pragma("unroll") for (int j = 0; j < 4; ++j) Y[k][j] = __builtin_nontemporal_load(yr_ + 64 * j); } } while (0)
#define P8_FINISH(V, Y, W, mm) do { const float w_[4] = {W.x, W.y, W.z, W.w}; \
    _Pragma("unroll") for (int k = 0; k < 4; ++k) _Pragma("unroll") for (int j = 0; j < 4; ++j) { const f32x2 lo_ = __builtin_amdgcn_cvt_pk_f32_fp8((int)Y[k][j], false), hi_ = __builtin_amdgcn_cvt_pk_f32_fp8((int)Y[k][j], true); \
        V[j] += (f32x4){lo_.x, lo_.y, hi_.x, hi_.y} * (w_[k] * 0.0625f); } \
    float s_ = 0.f; _Pragma("unroll") for (int j = 0; j < 4; ++j) s_ += (V[j].x * V[j].x + V[j].y * V[j].y) + (V[j].z * V[j].z + V[j].w * V[j].w); \
    const float rstd_ = 1.f / sqrtf(wave_sum(s_) * (1.f / 1024.f) + RMS_EPS); \
    if ((mm) < NTOK) { GAS f32x4* xo_ = (GAS f32x4*)(OUT + (size_t)(mm) * 1024) + F.lane; _Pragma("unroll") for (int j = 0; j < 4; ++j) __builtin_nontemporal_store((V[j] * rstd_) * gv[j], xo_ + 64 * j); } } while (0)
__device__ __forceinline__ void p8_combine(const Frame& F, const Args& a) {
    unsigned char* ws = a.ws;
    const LAS int* tab = (const LAS int*)(F.lds + MOETAB_OFF);
    const unsigned char* Y_ = ws + WS_Y; const v4u* TOKSLOT = (const v4u*)(ws + WS_TOKSLOT); const f32x4* TOKW = (const f32x4*)(ws + WS_TOKW);
    float* OUT = a.out; const bf16* X1B = (const bf16*)(ws + WS_X1B);
    f32x4 gv[4];
#pragma unroll
    for (int j = 0; j < 4; ++j) gv[j] = ((const GAS f32x4*)a.g_final)[F.lane + 64 * j];
    const int gw = F.vcu * 8 + F.wave, NGW = F.G * 8;
    f32x4 vA[4], vB[4]; unsigned yA[4][4], yB[4][4]; v4u sA, sB; f32x4 wA, wB, wC;
    int m = gw;
    P8_SLOTS(sA, wA, m); P8_ISSUE(vA, yA, sA, m); P8_SLOTS(sB, wB, m + NGW);
    for (; m < NTOK; m += 2 * NGW) {
        P8_ISSUE(vB, yB, sB, m + NGW);
        P8_SLOTS(sA, wC, m + 2 * NGW);
        P8_FINISH(vA, yA, wA, m);
        P8_ISSUE(vA, yA, sA, m + 2 * NGW);
        wA = wC; P8_SLOTS(sB, wC, m + 3 * NGW);
        P8_FINISH(vB, yB, wB, m + NGW);
        wB = wC;
    }
}
#undef P8_SLOTS
#undef P8_ISSUE
#undef P8_FINISH

constexpr int N_PHASES = 9;
typedef const __attribute__((address_space(4))) Args* KArgs;
__device__ __forceinline__ Args load_args(KArgs p) { Args a;
    a.x = p->x; a.g_mix = p->g_mix; a.w_in = p->w_in; a.conv_w = p->conv_w; a.b_f = p->b_f; a.w_conv_o = p->w_conv_o; a.w_attn_o = p->w_attn_o; a.w_out = p->w_out; a.g_ffn = p->g_ffn;
    a.w_router = p->w_router; a.b_router = p->b_router; a.w_gate_up = p->w_gate_up; a.b_gate_up = p->b_gate_up; a.w_down = p->w_down; a.b_down = p->b_down; a.g_final = p->g_final;
    a.out = p->out; a.ws = p->ws; a.ph_lo = p->ph_lo; a.ph_hi = p->ph_hi; a.li = p->li; a.pad = 0; return a; }
#define PHASE_ENV() \
    KArgs kp_ = (KArgs)__builtin_amdgcn_kernarg_segment_ptr(); asm volatile("" : "+s"(kp_)); const Args args = load_args(kp_); \
    Frame F; { int t_ = threadIdx.x; asm volatile("" : "+v"(t_)); int bx_ = blockIdx.x; asm volatile("" : "+s"(bx_)); int g_ = gridDim.x; asm volatile("" : "+s"(g_)); \
      F.lds = (LAS unsigned char*)lds; F.tid = t_; F.lane = t_ & 63; F.wave = __builtin_amdgcn_readfirstlane(t_ >> 6); F.G = g_; F.vcu = (g_ % 8 == 0) ? (bx_ % 8) * (g_ / 8) + bx_ / 8 : bx_; F.bx = bx_; } \
    unsigned char* ws = args.ws; (void)ws
__global__ void __launch_bounds__(512, 2) fwd_kernel(Args args_by_value) {
    extern __shared__ __attribute__((aligned(16))) unsigned char lds[];
    int lo, hi; XcdBarrier bar;
    {
        PHASE_ENV();
        for (int u = F.tid; u < (LDS_BYTES - LDSCTL_OFF) / 4; u += 512) ((LAS unsigned*)(F.lds + LDSCTL_OFF))[u] = 0u;
        __syncthreads();
        volatile LAS unsigned* MISC = (volatile LAS unsigned*)(F.lds + MISC_OFF);
        bar = xcd_barrier_post((unsigned*)(ws + WS_CTL) + CW_BAR + args.li * XCD_BAR_WORDS, MISC + 8);
        lo = args.ph_lo; hi = args.ph_hi;
    }
#ifndef PHMASK
#define PHMASK 0x1ff
#endif
#define IN(k) (((PHMASK >> (k)) & 1) && lo <= (k) && (k) < hi)
#define SEAM(k) do { if (lo <= (k) && (k) + 1 < hi) { PHASE_ENV(); xcd_barrier_fill(bar, F, args, ((k) >= 1 && (k) <= 4) && PROBE_REPEAT_PHASE < 0); } } while (0)

    if (IN(0)) { PHASE_ENV(); p0_prologue(F, args); }
    SEAM(0);
    if (IN(1)) {
        PHASE_ENV();
        { EpiG1 E{ws, attn_body::C2};
          SchedGrid S; S.o.init(NTOK / 256, 12, F.G, F.bx); S.A = (unsigned)WS_H; S.B = (unsigned)WS_WIN; S.atile = 256 * 1024 * 2; S.btile = 256 * 1024 * 2;
          pg8::gemm_phase<EpiG1, SchedGrid, false, true>(F.lds + RING_OFF, (const char*)ws, 1024, 1024, 16, S, E); }
        { SchedGrid S; S.o.init(NTOK / 256, 8, F.G, F.bx); S.A = (unsigned)WS_H8; S.B = (unsigned)WS_WG8; S.atile = 256 * 1024; S.btile = 256 * 1024;
          EpiGate E{ws};
          pg8::gemm_phase<EpiGate, SchedGrid, false, true, true>(F.lds + RING_OFF, (const char*)ws, 512, 512, 8, S, E, 0x7b7b7b7b  ); }
    }
    SEAM(1);
    if (IN(2)) {
        { PHASE_ENV(); p2_conv(F, args); }
        PHASE_ENV();
        const attn_body::bf16* Qp = (const attn_body::bf16*)(ws + WS_Q); const attn_body::bf16* Kp = (const attn_body::bf16*)(ws + WS_K); const attn_body::bf16* Vp = (const attn_body::bf16*)(ws + WS_V);
        attn_body::bf16* Op = (attn_body::bf16*)(ws + WS_H) + 512;
        for (int bh = F.vcu; bh < NBATCH * NHEADS; bh += F.G) {
            p2_keybias(F, (const float*)(ws + WS_LOGF), bh, (LAS float*)(F.lds + RING_OFF + attn_body::LDS_KB), (LAS float*)(F.lds + MISC_OFF + 64));
            attn_body::bf16x8 qr[4];
            for (int qb = attn_body::NQB - 1; qb >= 0; --qb) attn_body::attn_unit<60>(bh >> 3, bh & 7, qb, Qp, Kp, Vp, Op, (char*)lds + RING_OFF, qr);
            __syncthreads();
        }
    }
    SEAM(2);
    if (IN(3)) {
        PHASE_ENV();
        SchedMix S; S.o.init(NTOK / 256, 4, F.G, F.bx); S.A = (unsigned)WS_H; S.B = (unsigned)WS_W3; S.atile = 256 * 1024 * 2; S.btile = 256 * 1024 * 2;
        EpiMix E{ws + WS_G8, (bf16*)(ws + WS_MIX)};
        pg8::gemm_phase<EpiMix, SchedMix, false, true>(F.lds + RING_OFF, (const char*)ws, 1024, 1024, 8, S, E);
    }
    SEAM(3);
    if (IN(4)) {
        PHASE_ENV();
        SchedGrid S; S.o.init(NTOK / 256, 4, F.G, F.bx); S.A = (unsigned)WS_MIX; S.B = (unsigned)WS_WOUT; S.atile = 256 * 1024 * 2; S.btile = 256 * 1024 * 2;
        EpiOut E{args.x, (bf16*)(ws + WS_X1B)};
        pg8::gemm_phase<EpiOut, SchedGrid, false, true>(F.lds + RING_OFF, (const char*)ws, 1024, 1024, 16, S, E);
    }
    SEAM(4);
    if (IN(5)) { PHASE_ENV(); p5_router(F, args); cvt_drain(F, args, CVT_NGU); }
    SEAM(5);
    if (IN(6)) {
        PHASE_ENV();
        moe_table(F, args, 8);
        SchedMoe S; S.tab = (const LAS int*)(F.lds + MOETAB_OFF); S.G = F.G; S.c = F.bx; S.nct = 8; S.gather = 1;
        S.A = (unsigned)WS_H2; S.B = (unsigned)WS_WGU; S.list = (unsigned)WS_LIST; S.bexp = 2048u * 1024u; S.atile = 256u * 1024u; S.btile = 256u * 1024u;
        EpiSwiglu E{args.b_gate_up, ws + WS_ACT, (const LAS unsigned char*)(F.lds + GAUX_OFF), F.lds + P5_OFF};
        pg8::gemm_phase<EpiSwiglu, SchedMoe, true, true, true>(F.lds + RING_OFF, (const char*)ws, 512, 512, 8, S, E, 0x7a7a7a7a  , F.lds + GAUX_OFF);
        cvt_drain(F, args, CVT_NCH);
    }
    SEAM(6);
    if (IN(7)) {
        PHASE_ENV();
        moe_table(F, args, 4);
        SchedMoe S; S.tab = (const LAS int*)(F.lds + MOETAB_OFF); S.G = F.G; S.c = F.bx; S.nct = 4; S.gather = 0;
        S.A = (unsigned)WS_ACT; S.B = (unsigned)WS_WD; S.list = 0u; S.bexp = 1024u * 1024u; S.atile = 256u * 1024u; S.btile = 256u * 1024u;
        EpiDown E{args.b_down, ws + WS_Y, F.lds + P5_OFF};
        pg8::gemm_phase<EpiDown, SchedMoe, false, true, true>(F.lds + RING_OFF, (const char*)ws, 512, 512, 8, S, E, 0x7d7d7d7d  );
    }
    SEAM(7);
    if (IN(8)) { PHASE_ENV(); moe_table(F, args, 4); p8_combine(F, args); }
#undef IN
#undef SEAM
}

extern "C" void kernel_launch(void* const* d_in, const int* in_sizes, int n_in, void* d_out, int out_size, void* d_ws, size_t ws_size, hipStream_t stream) {
    static int grid = 0;
    if (grid == 0) {
        if (n_in != 16 || in_sizes[0] != NTOK * DMODEL || out_size != NTOK * DMODEL || ws_size < WS_END) { fprintf(stderr, "kernel_launch: unexpected shapes / workspace (%zu)\n", ws_size); grid = -1; return; }
        int dev = 0, cus = 0, per_cu = 0;
        if (hipGetDevice(&dev) != hipSuccess || hipDeviceGetAttribute(&cus, hipDeviceAttributeMultiprocessorCount, dev) != hipSuccess) { grid = -1; return; }
        if (hipFuncSetAttribute((const void*)fwd_kernel, hipFuncAttributeMaxDynamicSharedMemorySize, LDS_BYTES) != hipSuccess) { grid = -1; return; }
        if (hipOccupancyMaxActiveBlocksPerMultiprocessor(&per_cu, (const void*)fwd_kernel, 512, LDS_BYTES) != hipSuccess || per_cu < 1) fprintf(stderr, "kernel_launch: occupancy query reports %d\n", per_cu);
        (void)hipGetLastError();
        grid = cus;
    }
    if (grid < 0) return;
    if (hipMemsetAsync((char*)d_ws + WS_CTL, 0, CTL_ZERO_BYTES, stream) != hipSuccess) return;
    Args a{};
    a.x = (const float*)d_in[0]; a.g_mix = (const float*)d_in[1]; a.w_in = (const float*)d_in[2]; a.conv_w = (const float*)d_in[3]; a.b_f = (const float*)d_in[4];
    a.w_conv_o = (const float*)d_in[5]; a.w_attn_o = (const float*)d_in[6]; a.w_out = (const float*)d_in[7]; a.g_ffn = (const float*)d_in[8]; a.w_router = (const float*)d_in[9];
    a.b_router = (const float*)d_in[10]; a.w_gate_up = (const float*)d_in[11]; a.b_gate_up = (const float*)d_in[12]; a.w_down = (const float*)d_in[13]; a.b_down = (const float*)d_in[14];
    a.g_final = (const float*)d_in[15];
    a.out = (float*)d_out; a.ws = (unsigned char*)d_ws;
    if (PROBE_REPEAT_PHASE < 0) { a.ph_lo = 0; a.ph_hi = N_PHASES; a.li = 0; hipLaunchKernelGGL(fwd_kernel, dim3(grid), dim3(512), LDS_BYTES, stream, a); }
    else if (PROBE_REPEAT_PHASE == 80) {
        a.ph_lo = 0; a.ph_hi = 8; a.li = 0; hipLaunchKernelGGL(fwd_kernel, dim3(grid), dim3(512), LDS_BYTES, stream, a);
        (void)hipMemcpyAsync((char*)d_ws + WS_ACT, d_out, (size_t)NTOK * DMODEL * 4, hipMemcpyDeviceToDevice, stream);
        a.ph_lo = 8; a.ph_hi = 9; a.li = 1; if (PROBE_REPEAT_PHASE == 8) hipLaunchKernelGGL(fwd_kernel, dim3(grid), dim3(512), LDS_BYTES, stream, a);
        (void)hipMemcpyAsync(d_out, (char*)d_ws + WS_ACT, (size_t)NTOK * DMODEL * 4, hipMemcpyDeviceToDevice, stream);
        a.li = 2; hipLaunchKernelGGL(fwd_kernel, dim3(grid), dim3(512), LDS_BYTES, stream, a);
    }
    else {
        const int k = PROBE_REPEAT_PHASE; const int cuts[4] = {0, k + 1, k + 1, N_PHASES}; const int los[3] = {0, k, k + 1};
        for (int li = 0; li < 3; ++li) { a.ph_lo = los[li]; a.ph_hi = cuts[li + 1]; a.li = li; if (li == 1 && k == 5) (void)hipMemsetAsync((char*)d_ws + WS_CTL + CW_CNT * 4, 0, 256, stream);
            if (a.ph_lo < a.ph_hi) hipLaunchKernelGGL(fwd_kernel, dim3(grid), dim3(512), LDS_BYTES, stream, a); } }
}
```

```cpp
#include <hip/hip_runtime.h>
#include <hip/hip_bf16.h>
#include <cstdio>
#include <cstdint>
#include <cmath>

#ifndef PROBE_REPEAT_PHASE
#define PROBE_REPEAT_PHASE (-1)
#endif

constexpr int NTOK = 65536, DMODEL = 1024, SEQLEN = 2048, NBATCH = 32, NHEADS = 8;
constexpr int NEXP = 32, LISTCAP = NTOK;
constexpr int INCOLS = 5128;
constexpr float RMS_EPS = 1e-5f;

namespace pg8 {
#define PG8_LAS __attribute__((address_space(3)))
typedef unsigned short bf16_t;
typedef short bf16x8 __attribute__((ext_vector_type(8)));
typedef float f32x4 __attribute__((ext_vector_type(4)));
typedef float f32x2 __attribute__((ext_vector_type(2)));
typedef unsigned u32x4 __attribute__((ext_vector_type(4)));
typedef int i32x4 __attribute__((ext_vector_type(4)));
typedef int i32x8 __attribute__((ext_vector_type(8)));
constexpr int BM = 256, BK = 64, HALF = 128, HTB = HALF * BK * 2  , STAGE_BYTES = 8 * HTB, NXCD = 8, WGM = 8;

__host__ __device__ __forceinline__ int lds_byte(int r, int c) { const int st = (r >> 4) * 2 + (c >> 5), rr = r & 15, cc = c & 31, ob = rr * 64 + cc * 2; return st * 1024 + (ob ^ (((ob >> 9) & 1) << 5)); }
__host__ __device__ __forceinline__ void stage_rc(int b, int& R, int& C) { const int st = b / 1024, sb = b % 1024, swz = sb ^ (((sb >> 9) & 1) << 5); R = (st >> 1) * 16 + swz / 64; C = (st & 1) * 32 + (swz % 64) / 2; }
__host__ __device__ __forceinline__ int perm32(int rho) { const int n = rho >> 4, i = rho & 15; return 8 * (i >> 2) + 4 * n + (i & 3); }

struct Unit { unsigned A, B, rows; int pm, pn, e, nvalid, lrows; };

struct GridOrder {
    int nM, nN, nwg, G, c;
    __device__ __forceinline__ void init(int nM_, int nN_, int G_, int c_) { nM = nM_; nN = nN_; nwg = nM * nN; G = G_; c = c_; }
    __device__ __forceinline__ bool map(int i, int& pm, int& pn) const {
        const long L = (long)i * G + c; if (L >= nwg) return false;
        int wgid = (int)L; { const int q = nwg / NXCD, r = nwg % NXCD, xcd = wgid % NXCD, off = wgid / NXCD; wgid = (xcd < r ? xcd * (q + 1) : r * (q + 1) + (xcd - r) * q) + off; }
        const int nig = WGM * nN, gid = wgid / nig, fm = gid * WGM, gsz = (nM - fm) < WGM ? (nM - fm) : WGM;
        pm = fm + ((wgid % nig) % gsz); pn = (wgid % nig) / gsz; return true;
    }
};

__device__ __forceinline__ unsigned cvt_pk_bf16(float lo, float hi) { unsigned r; asm volatile("v_cvt_pk_bf16_f32 %0, %1, %2" : "=v"(r) : "v"(lo), "v"(hi)); return r; }
__device__ __forceinline__ float bf_lo(unsigned w) { return __uint_as_float(w << 16); }
__device__ __forceinline__ float bf_hi(unsigned w) { return __uint_as_float(w & 0xffff0000u); }

template <class Epi, class Sched, bool GATHER, bool ALIGN_EPI, bool FP8 = false>
__device__ __forceinline__ void gemm_phase(PG8_LAS unsigned char* lds, const char* base, const int lda, const int ldb, const int nt, const Sched& S, const Epi& E, const int sc0 = 0x7f7f7f7f, PG8_LAS unsigned char* gaux = nullptr) {
    const int tid = threadIdx.x, wid = __builtin_amdgcn_readfirstlane(tid >> 6), lane = tid & 63, wr = wid >> 2, wc = wid & 3, fr = lane & 15, fq = lane >> 4;
    unsigned voffA[2][2], voffB1[2];
#pragma unroll
    for (int i = 0; i < 2; ++i) { int R, C; stage_rc(tid * 16 + i * 8192, R, C); const int Rb = Epi::PERM ? ((R & ~31) + perm32(R & 31)) : R;
        voffB1[i] = (unsigned)(Rb * ldb + C) * 2u;
#pragma unroll
        for (int h = 0; h < 2; ++h) { voffA[h][i] = (unsigned)((R + (GATHER ? HALF * h : 0)) * lda + C) * 2u; } }
    const unsigned hstepA = GATHER ? 0u : (unsigned)(HALF * lda * 2), hstepB = (unsigned)(HALF * ldb * 2);
    const unsigned kstep = (unsigned)(BK * 2);
    const unsigned ldsw = (unsigned)wid * 1024u;
    const int aoff = lds_byte(wr * 64 + fr, fq * 8), boff = lds_byte(wc * 32 + fr, fq * 8);
#define PG8_SA(b, h) (((b) * 2 + (h)) * HTB)
#define PG8_SB(b, h) ((4 + (b) * 2 + (h)) * HTB)
#define PG8_STAGE(bufoff, gbase, voff) do { _Pragma("unroll") for (int _i = 0; _i < 2; ++_i) \
        __builtin_amdgcn_global_load_lds((const unsigned*)(base + (unsigned)((gbase) + (voff)[_i])), (PG8_LAS unsigned*)(lds + (bufoff) + ldsw + _i * 8192), 16, 0, 0); } while (0)
#define PG8_LDA(dst, b, h) do { _Pragma("unroll") for (int m = 0; m < 4; ++m) _Pragma("unroll") for (int k = 0; k < 2; ++k) dst[m][k] = *(const PG8_LAS bf16x8*)(lds + PG8_SA(b, h) + aoff + m * 2048 + k * 1024); } while (0)
#define PG8_LDB(dst, b, h) do { _Pragma("unroll") for (int n = 0; n < 2; ++n) _Pragma("unroll") for (int k = 0; k < 2; ++k) dst[n][k] = *(const PG8_LAS bf16x8*)(lds + PG8_SB(b, h) + boff + n * 2048 + k * 1024); } while (0)
#define PG8_CAT(X) __builtin_shufflevector(__builtin_bit_cast(i32x4, (X)[0]), __builtin_bit_cast(i32x4, (X)[1]), 0, 1, 2, 3, 4, 5, 6, 7)
#define PG8_MMA(ai, bj, At, Bt) do { __builtin_amdgcn_s_setprio(1); _Pragma("unroll") for (int m = 0; m < 4; ++m) _Pragma("unroll") for (int n = 0; n < 2; ++n) { \
        if constexpr (FP8) acc[ai][bj][m][n] = __builtin_amdgcn_mfma_scale_f32_16x16x128_f8f6f4(PG8_CAT(Bt[n]), PG8_CAT(At[m]), acc[ai][bj][m][n], 0, 0, 0, sc0, 0, sc0); \
        else { _Pragma("unroll") for (int k = 0; k < 2; ++k) acc[ai][bj][m][n] = __builtin_amdgcn_mfma_f32_16x16x32_bf16(Bt[n][k], At[m][k], acc[ai][bj][m][n], 0, 0, 0); } } \
        __builtin_amdgcn_s_setprio(0); } while (0)
#define PG8_WAIT_V(n) asm volatile("s_waitcnt vmcnt(" #n ")" ::: "memory")
#define PG8_WAIT_L(n) asm volatile("s_waitcnt lgkmcnt(" #n ")" ::: "memory")
#define PG8_BAR __builtin_amdgcn_s_barrier()
#define PG8_SCHED __builtin_amdgcn_sched_barrier(0)
#define PG8_LDMA(u, par) __builtin_amdgcn_global_load_lds((const unsigned*)(base + (u).rows + (unsigned)tid * 4u), (PG8_LAS unsigned*)(gaux + (par) * 2048 + wid * 256), 4, 0, 0)
#define PG8_GOFF(u, par, vo) do { int _tid = threadIdx.x; asm volatile("" : "+v"(_tid)); _Pragma("unroll") for (int _i = 0; _i < 2; ++_i) { int _R, _C; stage_rc(_tid * 16 + _i * 8192, _R, _C); \
        _Pragma("unroll") for (int _h = 0; _h < 2; ++_h) { \
        const int _r = _R + HALF * _h; const int _t = ((const PG8_LAS int*)(gaux + (par) * 2048))[2 * (_r < (u).nvalid ? _r : 0)]; (vo)[_h][_i] = (unsigned)(_t * lda + _C) * 2u; } } } while (0)
    Unit cur, nxt; int ui = 0;
    if (!S.next(0, cur)) return;
    f32x4 acc[2][2][4][2];
#pragma unroll
    for (int a = 0; a < 2; ++a)
#pragma unroll
        for (int b = 0; b < 2; ++b)
#pragma unroll
            for (int m = 0; m < 4; ++m)
#pragma unroll
                for (int n = 0; n < 2; ++n) acc[a][b][m][n] = (f32x4){0.f, 0.f, 0.f, 0.f};
    bf16x8 At[4][2], B0[2][2], B1[2][2];
    if constexpr (GATHER) { if constexpr (Epi::BIAS_LDS) E.bias_dma(cur, 0, tid, wid); PG8_LDMA(cur, 0); PG8_WAIT_V(0); PG8_BAR; PG8_GOFF(cur, 0, voffA); cur.lrows = 0; }
    if constexpr (!GATHER && Epi::BIAS_LDS) { E.bias_dma(cur, 0, tid, wid); cur.lrows = 0; }
    unsigned cA = cur.A, cB = cur.B;
    PG8_STAGE(PG8_SB(0, 0), cB, voffB1); PG8_STAGE(PG8_SB(0, 1), cB + hstepB, voffB1); PG8_STAGE(PG8_SA(0, 0), cA, voffA[0]); PG8_STAGE(PG8_SA(0, 1), cA + hstepA, voffA[1]);
    if (wr == 1) PG8_BAR;
    PG8_WAIT_V(2); PG8_BAR;
    PG8_STAGE(PG8_SB(1, 0), cB + kstep, voffB1); PG8_STAGE(PG8_SA(1, 0), cA + kstep, voffA[0]); PG8_STAGE(PG8_SB(1, 1), cB + kstep + hstepB, voffB1);
    PG8_WAIT_V(6); PG8_BAR;
    for (;;) {
        const bool has_next = S.next(ui + 1, nxt);
        const unsigned nA = has_next ? nxt.A : cA, nB = has_next ? nxt.B : cB;
        const int gbn = (ui + 1) % 3;
        if constexpr (!GATHER && Epi::BIAS_LDS) { if (has_next) { E.bias_dma(nxt, gbn, tid, wid); nxt.lrows = gbn * 2048; } }
        if constexpr (GATHER) { if (has_next) { if constexpr (Epi::BIAS_LDS) E.bias_dma(nxt, gbn, tid, wid); PG8_LDMA(nxt, gbn); nxt.lrows = gbn * 2048; } }
        for (int t = 0; t < nt; t += 2) {
            const bool last = (t == nt - 2);
            const unsigned a1 = cA + (unsigned)(t + 1) * kstep;
            const unsigned a2 = last ? nA : cA + (unsigned)(t + 2) * kstep, b2 = last ? nB : cB + (unsigned)(t + 2) * kstep;
            const unsigned a3 = a2 + kstep, b3 = b2 + kstep;
            PG8_LDB(B0, 0, 0); PG8_LDB(B1, 0, 1); PG8_SCHED; PG8_LDA(At, 0, 0); PG8_STAGE(PG8_SA(1, 1), a1 + hstepA, voffA[1]);
            if constexpr (GATHER) { if (last && has_next) { PG8_GOFF(nxt, gbn, voffA); } }
            PG8_WAIT_V(8); PG8_WAIT_L(0); PG8_BAR; PG8_MMA(0, 0, At, B0); PG8_MMA(0, 1, At, B1); PG8_BAR; PG8_SCHED;
            PG8_LDA(At, 0, 1); PG8_STAGE(PG8_SB(0, 0), b2, voffB1); PG8_STAGE(PG8_SB(0, 1), b2 + hstepB, voffB1); PG8_STAGE(PG8_SA(0, 0), a2, voffA[0]);
            PG8_WAIT_V(8); PG8_WAIT_L(0); PG8_BAR; PG8_MMA(1, 0, At, B0); PG8_MMA(1, 1, At, B1); PG8_BAR; PG8_SCHED;
            PG8_LDB(B0, 1, 0); PG8_LDB(B1, 1, 1); PG8_SCHED; PG8_LDA(At, 1, 0); PG8_STAGE(PG8_SA(0, 1), a2 + hstepA, voffA[1]);
            PG8_WAIT_V(8); PG8_WAIT_L(0); PG8_BAR; PG8_MMA(0, 0, At, B0); PG8_MMA(0, 1, At, B1); PG8_BAR; PG8_SCHED;
            PG8_LDA(At, 1, 1); PG8_STAGE(PG8_SB(1, 0), b3, voffB1); PG8_STAGE(PG8_SB(1, 1), b3 + hstepB, voffB1); PG8_STAGE(PG8_SA(1, 0), a3, voffA[0]);
            PG8_WAIT_V(8); PG8_WAIT_L(0); PG8_BAR; PG8_MMA(1, 0, At, B0); PG8_MMA(1, 1, At, B1); PG8_BAR; PG8_SCHED;
        }
        if constexpr (ALIGN_EPI) { if (wr == 0) PG8_BAR; }
        const bool keep = E(acc, cur);
        if (!has_next) break;
        if (!keep) {
            const unsigned z_ = (unsigned)(uintptr_t)(lds + STAGE_BYTES);
#pragma unroll
            for (int a = 0; a < 2; ++a)
#pragma unroll
                for (int b = 0; b < 2; ++b)
#pragma unroll
                    for (int m = 0; m < 4; ++m)
#pragma unroll
                        for (int n = 0; n < 2; ++n) asm volatile("ds_read_b128 %0, %1" : "=v"(acc[a][b][m][n]) : "v"(z_) : "memory");
        }
        cur = nxt; cA = nA; cB = nB; ++ui;
        if constexpr (ALIGN_EPI) { if (wr == 1) PG8_BAR; }
    }
    PG8_WAIT_V(0);
    if constexpr (!ALIGN_EPI) { if (wr == 0) PG8_BAR; }
    PG8_BAR;
#undef PG8_SA
#undef PG8_SB
#undef PG8_STAGE
#undef PG8_LDA
#undef PG8_LDB
#undef PG8_MMA
#undef PG8_CAT
#undef PG8_WAIT_V
#undef PG8_WAIT_L
#undef PG8_BAR
#undef PG8_SCHED
#undef PG8_GOFF
#undef PG8_LDMA
}
}

namespace attn_body {
using bf16=__hip_bfloat16;
using bf16x8=__attribute__((ext_vector_type(8)))short;
using s16x4=__attribute__((ext_vector_type(4)))short;
using f32x16=__attribute__((ext_vector_type(16)))float;
using f32x4v=__attribute__((ext_vector_type(4)))float;
using u32x4=__attribute__((ext_vector_type(4)))unsigned;
constexpr int BATCH=NBATCH,NHEAD=NHEADS,SEQ=SEQLEN,D=64,DM=NHEAD*D,ODM=1024;
constexpr int NW=8,QBLK=32,QB=QBLK*NW,KVBLK=64,NQB=SEQ/QB;
__device__ __forceinline__ int crow(int r,int hi){return (r&3)+8*(r>>2)+4*hi;}
#define SBAR() __builtin_amdgcn_sched_barrier(0)
__device__ __forceinline__ void cmask(f32x16&p0,f32x16&p1,int jb,int qrel,int hi){
  const float NEG=-INFINITY; int kb=64*jb+4*hi;
  #pragma unroll
  for(int r=0;r<16;++r){int kv=kb+(r&3)+8*(r>>2); if(kv>qrel)p0[r]=NEG; if(kv+32>qrel)p1[r]=NEG;}
}
constexpr int NSLOT=3, SLOTB=8192;
constexpr int LDS_K=0, LDS_V=NSLOT*SLOTB, LDS_WS=2*NSLOT*SLOTB, LDS_OST=LDS_WS+NW*64*4, LDS_KB=LDS_OST+NW*4096, LDS_BYTES=LDS_KB+SEQ*4;
constexpr float C2=0.125f*1.4426950408889634f;
__device__ __forceinline__ void glds16(const void*gsrc,unsigned lds_dst){unsigned keep;
  asm volatile("s_mov_b32 %0, m0\n\ts_mov_b32 m0, %2\n\ts_nop 0\n\tglobal_load_lds_dwordx4 %1, off\n\ts_mov_b32 m0, %0":"=&s"(keep):"v"(gsrc),"s"(lds_dst):"memory");}
__device__ __forceinline__ float max3f(float a,float b,float c){float r;asm("v_max3_f32 %0, %1, %2, %3":"=v"(r):"v"(a),"v"(b),"v"(c));return r;}
__device__ __forceinline__ float max2f(float a,float b){float r;asm("v_max_f32_e32 %0, %1, %2":"=v"(r):"v"(a),"v"(b));return r;}
__device__ __forceinline__ float fadd_s(float a,float b){float r;asm("v_add_f32_e32 %0, %1, %2":"=v"(r):"v"(a),"v"(b));return r;}
__device__ __forceinline__ float fsub_s(float a,float b){float r;asm("v_sub_f32_e32 %0, %1, %2":"=v"(r):"v"(a),"v"(b));return r;}
typedef float f32x2_t __attribute__((ext_vector_type(2))); typedef __bf16 bf16x2_t __attribute__((ext_vector_type(2)));
__device__ __forceinline__ unsigned cvtpk_s(float lo,float hi){f32x2_t v={lo,hi};bf16x2_t b=__builtin_convertvector(v,bf16x2_t);return __builtin_bit_cast(unsigned,b);}
#define WAIT_BAR(N) asm volatile("s_waitcnt vmcnt(" #N ") lgkmcnt(0)\n\ts_barrier":::"memory")

__device__ __forceinline__ void qkt(f32x16&p0,f32x16&p1,const char*Kslot,const bf16x8*qr,int r32,int hi){
  const char*kb=Kslot+hi*1024+r32*16;
  #pragma unroll
  for(int d0=0;d0<4;++d0){
    const bf16x8 b0=*reinterpret_cast<const bf16x8*>(kb+d0*2048);
    const bf16x8 b1=*reinterpret_cast<const bf16x8*>(kb+d0*2048+512);
    p0=__builtin_amdgcn_mfma_f32_32x32x16_bf16(b0,qr[d0],p0,0,0,0);p1=__builtin_amdgcn_mfma_f32_32x32x16_bf16(b1,qr[d0],p1,0,0,0);}
}
typedef __attribute__((address_space(3))) const char* lds_cptr;
typedef short v4i16_t __attribute__((ext_vector_type(4)));
__device__ __forceinline__ void kload8(bf16x8*kf,lds_cptr kp){
  kf[0]=*(const __attribute__((address_space(3))) bf16x8*)(kp);      kf[1]=*(const __attribute__((address_space(3))) bf16x8*)(kp+512);
  kf[2]=*(const __attribute__((address_space(3))) bf16x8*)(kp+2048); kf[3]=*(const __attribute__((address_space(3))) bf16x8*)(kp+2560);
  kf[4]=*(const __attribute__((address_space(3))) bf16x8*)(kp+4096); kf[5]=*(const __attribute__((address_space(3))) bf16x8*)(kp+4608);
  kf[6]=*(const __attribute__((address_space(3))) bf16x8*)(kp+6144); kf[7]=*(const __attribute__((address_space(3))) bf16x8*)(kp+6656);
}
__device__ __forceinline__ void kload2(bf16x8*kf,lds_cptr kp,int j){ kf[2*j]=*(const __attribute__((address_space(3))) bf16x8*)(kp+j*2048); kf[2*j+1]=*(const __attribute__((address_space(3))) bf16x8*)(kp+j*2048+512); }
__device__ __forceinline__ s16x4 vtr(lds_cptr p){ return __builtin_bit_cast(s16x4,__builtin_amdgcn_ds_read_tr16_b64_v4i16((__attribute__((address_space(3))) v4i16_t*)p)); }
__device__ __forceinline__ float rowmax(const f32x16&p0,const f32x16&p1){
  float a=max3f(p0[0],p0[1],p1[0]),b=max3f(p0[2],p0[3],p1[1]);a=max3f(a,p1[2],p1[3]);
  #pragma unroll
  for(int r=4;r<16;r+=4){a=max3f(a,p0[r],p0[r+1]);b=max3f(b,p0[r+2],p0[r+3]);a=max3f(a,p1[r],p1[r+1]);b=max3f(b,p1[r+2],p1[r+3]);}
  const float m=max2f(a,b);
  auto rr=__builtin_amdgcn_permlane32_swap(__float_as_uint(m),__float_as_uint(m),false,false);
  return max2f(__uint_as_float(rr[0]),__uint_as_float(rr[1]));
}
__device__ __forceinline__ void pv(f32x16*o,int vb,bf16x8 pa0,bf16x8 pa1,bf16x8 pa2,bf16x8 pa3){
  #pragma unroll
  for(int d0=0;d0<2;++d0){s16x4 lo[4],hi[4];
    #pragma unroll
    for(int ks=0;ks<4;++ks){
      asm volatile("ds_read_b64_tr_b16 %0,%1 offset:%c2":"=&v"(lo[ks]):"v"(vb),"i"(d0*4096+ks*1024):"memory");
      asm volatile("ds_read_b64_tr_b16 %0,%1 offset:%c2":"=&v"(hi[ks]):"v"(vb),"i"(d0*4096+ks*1024+512):"memory");}
    asm volatile("s_waitcnt lgkmcnt(0)":::"memory");SBAR();
    #define PK(k) (bf16x8){lo[k][0],lo[k][1],lo[k][2],lo[k][3],hi[k][0],hi[k][1],hi[k][2],hi[k][3]}
    o[d0]=__builtin_amdgcn_mfma_f32_32x32x16_bf16(pa0,PK(0),o[d0],0,0,0);
    o[d0]=__builtin_amdgcn_mfma_f32_32x32x16_bf16(pa1,PK(1),o[d0],0,0,0);
    o[d0]=__builtin_amdgcn_mfma_f32_32x32x16_bf16(pa2,PK(2),o[d0],0,0,0);
    o[d0]=__builtin_amdgcn_mfma_f32_32x32x16_bf16(pa3,PK(3),o[d0],0,0,0);
    #undef PK
  }
}
#define ATTN_STORE16(p,v) (*(u32x4*)(p)=(v))
template<int THRL> __device__ __forceinline__ void attn_unit(int b,int h,int qb,const bf16*Q,const bf16*__restrict__ K,const bf16*__restrict__ V,bf16*O,char*shm,bf16x8(&qr)[4]){
  int tid=threadIdx.x; asm volatile("":"+v"(tid));
  const int lane=tid&63,r32=lane&31,hi=lane>>5; const int wid=__builtin_amdgcn_readfirstlane(tid>>6);
  const long rowbase=(long)b*SEQ; const int q0=qb*QB;
  const bf16*Qw=Q+(rowbase+q0+wid*QBLK)*DM+h*D;
  const bf16*Kh=K+rowbase*DM+h*D,*Vh=V+rowbase*DM+h*D;
  const unsigned lds0=(unsigned)(uintptr_t)shm;
  float*wsf=(float*)(shm+LDS_WS)+wid*64;
  const bf16*ksrc=Kh+(long)lane*DM+wid*8;
  const bf16*vsrc=Vh+(long)(16*(wid&3)+(lane>>2))*DM+(wid>>2)*32+(lane&3)*8;
  const unsigned kdst=lds0+LDS_K+wid*1024, vdst=lds0+LDS_V+wid*1024;
  #define DMA_K(t,slot) glds16(ksrc+(long)(t)*KVBLK*DM,(unsigned)__builtin_amdgcn_readfirstlane(kdst+(slot)))
  #define DMA_V(t,slot) glds16(vsrc+(long)(t)*KVBLK*DM,(unsigned)__builtin_amdgcn_readfirstlane(vdst+(slot)))
  const int vb0=(int)(lds0+LDS_V)+((lane>>4)&1)*32+(lane&3)*8+(4*hi+((lane&15)>>2))*64;
  const char*Kbase=shm+LDS_K; bf16x8 kf[8];
  const lds_cptr shm3=(lds_cptr)shm; const lds_cptr kp0=shm3+LDS_K+hi*1024+r32*16; const lds_cptr vp0=shm3+LDS_V+((lane>>4)&1)*32+(lane&3)*8+(4*hi+((lane&15)>>2))*64;
  const lds_cptr kbp=shm3+LDS_KB+hi*16;
  const int NT=(q0+QB)/KVBLK;
  if(qb==NQB-1){DMA_K(0,0);DMA_V(0,0);DMA_K(1,SLOTB);}
  if(qb==NQB-1){
    #pragma unroll
    for(int d0=0;d0<4;++d0)qr[d0]=*reinterpret_cast<const bf16x8*>(&Qw[(long)r32*DM+d0*16+hi*8]); }
  float mhat=0.f,l_reg=0.f;f32x16 o[2];o[0]=f32x16{};o[1]=f32x16{};
  const int qrel=wid*QBLK+r32;
  #define CINIT(X0,X1,tt) do{ const lds_cptr p_=kbp+(tt)*256; \
    _Pragma("unroll") for(int g_=0;g_<4;++g_){ \
      const f32x4v a_=*(const __attribute__((address_space(3))) f32x4v*)(p_+32*g_); const f32x4v b_=*(const __attribute__((address_space(3))) f32x4v*)(p_+128+32*g_); \
      X0[4*g_]=a_[0]-mhat; X0[4*g_+1]=a_[1]-mhat; X0[4*g_+2]=a_[2]-mhat; X0[4*g_+3]=a_[3]-mhat; \
      X1[4*g_]=b_[0]-mhat; X1[4*g_+1]=b_[1]-mhat; X1[4*g_+2]=b_[2]-mhat; X1[4*g_+3]=b_[3]-mhat; } }while(0)
  #define CMASK(P0,P1,t) do{int jb_=(t)-(NT-4); if(jb_>=0)cmask(P0,P1,jb_,qrel,hi);}while(0)
  bool resc=false;
  #define START(P0,P1) do{ const float rm=rowmax(P0,P1); resc=false; \
    { const float dl=rm; mhat=fadd_s(mhat,dl); \
      _Pragma("unroll") for(int r=0;r<16;++r){P0[r]=fsub_s(P0[r],dl);P1[r]=fsub_s(P1[r],dl);} } \
    _Pragma("unroll") for(int r=0;r<16;++r)P0[r]=__builtin_amdgcn_exp2f(P0[r]); }while(0)
  #define RESC() do{ if(resc){ asm volatile("s_waitcnt lgkmcnt(0)":::"memory"); \
      _Pragma("unroll") for(int d_=0;d_<2;++d_) _Pragma("unroll") for(int r=0;r<16;++r)o[d_][r]*=wsf[crow(r,hi)]; } }while(0)
  f32x16 pA0,pA1,pB0,pB1;
  int sl_prev=0,sl_cur=0,sl_next=SLOTB;
  #define ROT() do{sl_prev=sl_cur;sl_cur=sl_next;sl_next=(sl_next==(NSLOT-1)*SLOTB)?0:sl_next+SLOTB;}while(0)
  DMA_K(2,2*SLOTB);
  CINIT(pA0,pA1,0);
  WAIT_BAR(3);
  qkt(pA0,pA1,Kbase,qr,r32,hi);asm volatile("s_nop 15\n\ts_nop 7":"+v"(pA0),"+v"(pA1));CMASK(pA0,pA1,0);
  START(pA0,pA1);
  _Pragma("unroll") for(int r=0;r<16;++r)pA1[r]=__builtin_amdgcn_exp2f(pA1[r]);
  CINIT(pB0,pB1,1);
  WAIT_BAR(0);
  DMA_K(3,0);DMA_V(1,SLOTB);
  ROT();
  kload8(kf,kp0+sl_cur);
  WAIT_BAR(2);
  s16x4 vlo[8],vhi[8]; u32x4 pw0,pw1,pw2,pw3;
  #define PKW(P,B) cvtpk_s(P[B],P[B+1])
  #define PAF(k) __builtin_bit_cast(bf16x8,pw##k)
  #define VFR(i) (bf16x8){vlo[i][0],vlo[i][1],vlo[i][2],vlo[i][3],vhi[i][0],vhi[i][1],vhi[i][2],vhi[i][3]}
  #define PIN(x) asm volatile("":"+v"(x))
  #define MX3(a,b,c) __builtin_fmaxf(__builtin_fmaxf((a),(b)),(c))
  #define GAPA(MF,A0,A1,A2,A3,W0,W1,PW) do{ MF; sacc+=A0; sacc+=A1; sacc+=A2; sacc+=A3; PIN(sacc); W0; W1; PIN(PW); SBAR(); }while(0)
  #define EX(v) __builtin_amdgcn_exp2f(v)
  #define GAPB(MF,X,B) do{ MF; X[B]=EX(X[B]); X[B+1]=EX(X[B+1]); X[B+2]=EX(X[B+2]); X[B+3]=EX(X[B+3]); PIN(X); SBAR(); }while(0)
  #define VRD(i) do{ vlo[i]=vtr(vp_+(((i)>>2)*4096+((i)&3)*1024)); vhi[i]=vtr(vp_+(((i)>>2)*4096+((i)&3)*1024+512)); }while(0)
  #define KRD(G,j) do{ if(G){ kload2(kf,kp0+sl_next,j); SBAR(); } }while(0)
  #define STEP(C0,C1,P0,P1,t,GK,GV,GL) do{ SBAR(); \
    const lds_cptr vp_=vp0+sl_prev; \
    VRD(0); SBAR(); float sacc=(P0[0]+P0[1]); \
    GAPA(C0=__builtin_amdgcn_mfma_f32_32x32x16_bf16(kf[0],qr[0],C0,0,0,0), P0[2],P0[3],P0[4],P0[5],     pw0[0]=PKW(P0,0), pw0[1]=PKW(P0,2), pw0); \
    VRD(4); SBAR(); GAPA(C1=__builtin_amdgcn_mfma_f32_32x32x16_bf16(kf[1],qr[0],C1,0,0,0), P0[6],P0[7],P0[8],P0[9],     pw0[2]=PKW(P0,4), pw0[3]=PKW(P0,6), pw0); \
    VRD(1); SBAR(); GAPA(C0=__builtin_amdgcn_mfma_f32_32x32x16_bf16(kf[2],qr[1],C0,0,0,0),   P0[10],P0[11],P0[12],P0[13], pw1[0]=PKW(P0,8), pw1[1]=PKW(P0,10), pw1); \
    VRD(5); SBAR(); GAPA(C1=__builtin_amdgcn_mfma_f32_32x32x16_bf16(kf[3],qr[1],C1,0,0,0),   P0[14],P0[15],P1[0],P1[1],   pw1[2]=PKW(P0,12),pw1[3]=PKW(P0,14), pw1); \
    VRD(2); SBAR(); GAPA(C0=__builtin_amdgcn_mfma_f32_32x32x16_bf16(kf[4],qr[2],C0,0,0,0),   P1[2],P1[3],P1[4],P1[5],     pw2[0]=PKW(P1,0), pw2[1]=PKW(P1,2), pw2); \
    VRD(6); SBAR(); GAPA(C1=__builtin_amdgcn_mfma_f32_32x32x16_bf16(kf[5],qr[2],C1,0,0,0),   P1[6],P1[7],P1[8],P1[9],     pw2[2]=PKW(P1,4), pw2[3]=PKW(P1,6), pw2); \
    VRD(3); SBAR(); GAPA(C0=__builtin_amdgcn_mfma_f32_32x32x16_bf16(kf[6],qr[3],C0,0,0,0),   P1[10],P1[11],P1[12],P1[13], pw3[0]=PKW(P1,8), pw3[1]=PKW(P1,10), pw3); \
    VRD(7); SBAR(); GAPA(C1=__builtin_amdgcn_mfma_f32_32x32x16_bf16(kf[7],qr[3],C1,0,0,0),   P1[14],P1[15],0.f,0.f,       pw3[2]=PKW(P1,12),pw3[3]=PKW(P1,14), pw3); \
    l_reg+=sacc; \
    if(GK){DMA_K((t)+3,sl_cur);} if(GV){DMA_V((t)+1,sl_next);} \
    CMASK(C0,C1,t); \
    { float a=MX3(C0[0],C0[1],C1[0]),b=MX3(C0[2],C0[3],C1[1]); a=MX3(a,C1[2],C1[3]); \
      _Pragma("unroll") for(int r=4;r<16;r+=4){a=MX3(a,C0[r],C0[r+1]);b=MX3(b,C0[r+2],C0[r+3]);a=MX3(a,C1[r],C1[r+1]);b=MX3(b,C1[r+2],C1[r+3]);} \
      float rm=__builtin_fmaxf(a,b); { auto rr=__builtin_amdgcn_permlane32_swap(__float_as_uint(rm),__float_as_uint(rm),false,false); rm=__builtin_fmaxf(__uint_as_float(rr[0]),__uint_as_float(rr[1])); } \
      resc=false; \
      if(__builtin_expect(__any(rm>(float)THRL),0)){ const float dl=__builtin_fmaxf(rm,0.f); mhat+=dl; \
        _Pragma("unroll") for(int r=0;r<16;++r){C0[r]-=dl;C1[r]-=dl;} \
        const float f=__builtin_amdgcn_exp2f(-dl); l_reg*=f; if(hi==0)wsf[r32]=f; resc=true; } } \
    SBAR(); \
    GAPB(o[0]=__builtin_amdgcn_mfma_f32_32x32x16_bf16(PAF(0),VFR(0),o[0],0,0,0), C0,0); \
    GAPB(o[1]=__builtin_amdgcn_mfma_f32_32x32x16_bf16(PAF(0),VFR(4),o[1],0,0,0), C0,4); \
    KRD(GL,0); GAPB(o[0]=__builtin_amdgcn_mfma_f32_32x32x16_bf16(PAF(1),VFR(1),o[0],0,0,0), C0,8); \
    KRD(GL,1); GAPB(o[1]=__builtin_amdgcn_mfma_f32_32x32x16_bf16(PAF(1),VFR(5),o[1],0,0,0), C0,12); \
    KRD(GL,2); GAPB(o[0]=__builtin_amdgcn_mfma_f32_32x32x16_bf16(PAF(2),VFR(2),o[0],0,0,0), C1,0); \
    KRD(GL,3); GAPB(o[1]=__builtin_amdgcn_mfma_f32_32x32x16_bf16(PAF(2),VFR(6),o[1],0,0,0), C1,4); \
    GAPB(o[0]=__builtin_amdgcn_mfma_f32_32x32x16_bf16(PAF(3),VFR(3),o[0],0,0,0), C1,8); \
    GAPB(o[1]=__builtin_amdgcn_mfma_f32_32x32x16_bf16(PAF(3),VFR(7),o[1],0,0,0), C1,12); \
    if(GL){ CINIT(P0,P1,(t)+1); } \
    }while(0)
  int t=1;
  #undef CMASK
  #define CMASK(P0,P1,t) do{}while(0)
  for(;t+5<NT;t+=2){
    STEP(pB0,pB1,pA0,pA1,t,true,true,true);     WAIT_BAR(2); RESC(); ROT();
    STEP(pA0,pA1,pB0,pB1,t+1,true,true,true);   WAIT_BAR(2); RESC(); ROT();
  }
  #undef CMASK
  #define CMASK(P0,P1,t) do{int jb_=(t)-(NT-4); if(jb_>=0)cmask(P0,P1,jb_,qrel,hi);}while(0)
  #define ENDW(tt) do{ if((tt)+3<NT){WAIT_BAR(2);} else if((tt)+2<NT){WAIT_BAR(1);} else {WAIT_BAR(0);} }while(0)
  for(;t+1<NT;t+=2){
    STEP(pB0,pB1,pA0,pA1,t,(t+3<NT),(t+1<NT),(t+1<NT));       ENDW(t);   RESC(); ROT();
    STEP(pA0,pA1,pB0,pB1,t+1,(t+4<NT),(t+2<NT),(t+2<NT));     ENDW(t+1); RESC(); ROT();
  }
  STEP(pB0,pB1,pA0,pA1,NT-1,false,false,false); RESC();
  { float sacc=pB0[0]+pB0[1]; _Pragma("unroll") for(int r=2;r<16;++r)sacc+=pB0[r]; _Pragma("unroll") for(int r=0;r<16;++r)sacc+=pB1[r]; l_reg+=sacc;
    pw0=(u32x4){PKW(pB0,0),PKW(pB0,2),PKW(pB0,4),PKW(pB0,6)};pw1=(u32x4){PKW(pB0,8),PKW(pB0,10),PKW(pB0,12),PKW(pB0,14)};pw2=(u32x4){PKW(pB1,0),PKW(pB1,2),PKW(pB1,4),PKW(pB1,6)};pw3=(u32x4){PKW(pB1,8),PKW(pB1,10),PKW(pB1,12),PKW(pB1,14)};
    SBAR(); pv(o,vb0+sl_cur,PAF(0),PAF(1),PAF(2),PAF(3)); }
  if(qb>0){ asm volatile("s_barrier":::"memory"); DMA_K(0,0);DMA_V(0,0);DMA_K(1,SLOTB);
    const bf16*Qn=Qw-(long)QB*DM;
    #pragma unroll
    for(int d0=0;d0<4;++d0)qr[d0]=*reinterpret_cast<const bf16x8*>(&Qn[(long)r32*DM+d0*16+hi*8]); }
  #undef PKW
  #undef PAF
  #undef VFR
  #undef PIN
  #undef MX3
  #undef GAPA
  #undef GAPB
  #undef EX
  #undef VRD
  #undef KRD
  #undef STEP
  #undef ENDW
  {auto rr=__builtin_amdgcn_permlane32_swap(__float_as_uint(l_reg),__float_as_uint(l_reg),false,false);l_reg=__uint_as_float(rr[0])+__uint_as_float(rr[1]);}
  if(hi==0)wsf[32+r32]=l_reg;asm volatile("s_waitcnt lgkmcnt(0)":::"memory");
  float rli[16];
  #pragma unroll
  for(int r=0;r<16;++r)rli[r]=__builtin_amdgcn_rcpf(wsf[32+crow(r,hi)]);
  bf16*Ow=O+(rowbase+q0+wid*QBLK)*ODM+h*D;
  { bf16*stg=(bf16*)(shm+LDS_OST)+wid*2048;
    #pragma unroll
    for(int r=0;r<16;++r){const int orow=crow(r,hi);
      #pragma unroll
      for(int d0=0;d0<2;++d0)stg[orow*64+d0*32+r32]=__float2bfloat16(o[d0][r]*rli[r]);}
    asm volatile("s_waitcnt lgkmcnt(0)":::"memory");
    #pragma unroll
    for(int i=0;i<4;++i){const int row=i*8+(lane>>3),ch=lane&7; const u32x4 v=*(const u32x4*)(stg+row*64+ch*8); ATTN_STORE16(Ow+(long)row*ODM+ch*8,v);} }
  asm volatile("s_waitcnt lgkmcnt(0)\n\ts_barrier":::"memory");
  #undef DMA_K
  #undef DMA_V
  #undef CMASK
  #undef CINIT
  #undef START
  #undef RESC
  #undef ROT
}
#undef SBAR
#undef WAIT_BAR
}

constexpr size_t MiB = 1u << 20;
constexpr size_t WS_CTL = 0, CTL_ZERO_BYTES = 96 * 1024;
constexpr size_t WS_RIMG = 1 * MiB;
constexpr size_t WS_WIN = 2 * MiB;
constexpr size_t WS_W3 = 12 * MiB;
constexpr size_t WS_WOUT = 14 * MiB;
constexpr size_t WS_WGU = 16 * MiB;
constexpr size_t WS_WD = 80 * MiB;
constexpr size_t WS_H = 112 * MiB;
constexpr size_t WS_CB = 240 * MiB;
constexpr size_t WS_UC = 304 * MiB;
constexpr size_t WS_MIX = 688 * MiB;
constexpr size_t WS_Q = 368 * MiB, WS_K = 432 * MiB, WS_V = 496 * MiB;
constexpr size_t WS_R = 560 * MiB;
constexpr size_t WS_G8 = WS_R;
constexpr size_t WS_ACT = 304 * MiB;
constexpr size_t WS_Y = 568 * MiB;
constexpr size_t WS_H8 = 816 * MiB;
constexpr size_t WS_WG8 = 880 * MiB;
constexpr size_t WS_X1B = 112 * MiB;
constexpr size_t WS_H2 = 240 * MiB;
constexpr size_t WS_LOGF = 968 * MiB;
constexpr size_t WS_LIST = 970 * MiB;
constexpr size_t WS_TOKSLOT = 986 * MiB;
constexpr size_t WS_TOKW = 987 * MiB;
constexpr size_t WS_END = 988 * MiB;
static_assert(WS_H2 + (size_t)NTOK * 1024 <= WS_ACT && WS_ACT + (size_t)1056 * 256 * 1024 <= WS_Y && WS_Y + (size_t)1056 * 256 * 1024 <= WS_LOGF && WS_X1B + (size_t)NTOK * 2048 <= WS_H2 && WS_H2 == WS_CB && WS_X1B == WS_H, "MoE buffers");
constexpr int CW_BAR = 4096;
constexpr int CW_CNT = 16384;
constexpr int CW_CVT = 20480;
constexpr int CVT_NGU = 32 * 8 * 64 / 8;
constexpr int CVT_NCH = CVT_NGU + 32 * 8 * 32 / 8;
#ifndef CVT_STOP
#define CVT_STOP 3u
#endif

constexpr int RING_OFF = 0, RING_BYTES = 131072;
constexpr int LDSCTL_OFF = RING_BYTES, MISC_OFF = LDSCTL_OFF + 320;
constexpr int MOETAB_OFF = LDSCTL_OFF + 1024;
constexpr int P5_OFF = LDSCTL_OFF + 2048;
constexpr int GAUX_OFF = LDSCTL_OFF + 8192;
constexpr int LDS_BYTES = 147456;
static_assert(P5_OFF + (64 + 1024) * 4 <= GAUX_OFF && GAUX_OFF + 8192 <= LDS_BYTES && attn_body::LDS_BYTES <= RING_BYTES, "LDS map");

#define GAS __attribute__((address_space(1)))
#define LAS __attribute__((address_space(3)))
typedef unsigned short bf16;
typedef unsigned v4u __attribute__((ext_vector_type(4)));
typedef unsigned v2u __attribute__((ext_vector_type(2)));
typedef float f32x4 __attribute__((ext_vector_type(4)));
typedef GAS unsigned gu32;
#define RLX_AGENT __ATOMIC_RELAXED, __HIP_MEMORY_SCOPE_AGENT
#define LDS_WAIT() asm volatile("s_waitcnt lgkmcnt(0)" ::: "memory")
#define VM_WAIT() asm volatile("s_waitcnt vmcnt(0)" ::: "memory")
__device__ __forceinline__ unsigned f2bf(float f) { unsigned u = __builtin_bit_cast(unsigned, f); return (u + 0x7fffu + ((u >> 16) & 1u)) >> 16; }
__device__ __forceinline__ unsigned pk2(float lo, float hi) { return f2bf(lo) | (f2bf(hi) << 16); }

#define XB_TMO      128
#define XB_MISMAP   192
#define XB_XCNT(j)  (256  + 64 * (j))
#define XB_XSUB(j)  (1280 + 64 * (j))
#define XB_XGEN(j)  (2304 + 64 * (j))
#define XB_TOP      3328
#define XB_TOPGEN   3392
#define XCD_BAR_WORDS 3456
#define XB_SPIN_CAP (1u << 18)
__device__ __forceinline__ unsigned xb_ld(unsigned* p)              { return __hip_atomic_load(p, __ATOMIC_RELAXED, __HIP_MEMORY_SCOPE_AGENT); }
__device__ __forceinline__ unsigned xb_add(unsigned* p, unsigned v) { return __hip_atomic_fetch_add(p, v, __ATOMIC_RELAXED, __HIP_MEMORY_SCOPE_AGENT); }
__device__ __forceinline__ unsigned xb_xcc_id() { return (unsigned)__builtin_amdgcn_s_getreg((3 << 11) | 20) & 0xFu; }
#define XB_SPIN(cond, bar) do { unsigned _sp = 0; while (cond) { __builtin_amdgcn_s_sleep(1); \
    if ((++_sp & 255u) == 0u) { if (xb_ld(&(bar)[XB_TMO])) break; if (_sp > XB_SPIN_CAP) { atomicAdd(&(bar)[XB_TMO], 1u); break; } } } } while (0)
struct XcdBarrier { unsigned* bar; unsigned x; volatile LAS unsigned* st; };
__device__ __forceinline__ XcdBarrier xcd_barrier_post(unsigned* bar, volatile LAS unsigned* st) {
    XcdBarrier b; b.bar = bar; b.x = xb_xcc_id(); b.st = st;
    if (threadIdx.x == 0) {
        if (b.x != (blockIdx.x & 7u)) { const unsigned r = xb_add(&bar[XB_MISMAP], 1u); asm volatile("" :: "v"(r)); }
        (void)xb_add(&bar[XB_XCNT(b.x)], 1u);
    }
    return b;
}
__device__ __forceinline__ void xcd_barrier_complete(unsigned* bar, unsigned x, unsigned& nloc, unsigned& nx) {
    const unsigned G = gridDim.x * gridDim.y * gridDim.z;
    unsigned sum, cnt, mine, even, sp = 0u;
    for (;;) {
        sum = 0u; cnt = 0u; mine = 0u; even = 1u;
#pragma unroll
        for (unsigned j = 0; j < 16; ++j) { const unsigned c = xb_ld(&bar[XB_XCNT(j)]); sum += c; cnt += (c > 0u) ? 1u : 0u; mine = (j == x) ? c : mine; even &= (c == (j < 8u ? G / 8u : 0u)) ? 1u : 0u; }
        if (sum == G) break;
        __builtin_amdgcn_s_sleep(1);
        if ((++sp & 255u) == 0u) { if (xb_ld(&bar[XB_TMO])) break; if (sp > XB_SPIN_CAP) { atomicAdd(&bar[XB_TMO], 1u); break; } }
    }
    nloc = mine > 0u ? mine : 1u; nx = cnt > 0u ? cnt : 1u;
    if (even && G == 256u && (G & 7u) == 0u && xb_ld(&bar[XB_MISMAP]) == 0u && xb_ld(&bar[XB_TMO]) == 0u) nx |= 0x10000u;
}
__device__ __forceinline__ void xcd_barrier(const XcdBarrier& b) {
    asm volatile("s_waitcnt vmcnt(0)" ::: "memory");
    __syncthreads();
    if (threadIdx.x == 0) {
        unsigned* bar = b.bar;
        __builtin_amdgcn_s_waitcnt(0);
        unsigned nloc = b.st[0], nx = b.st[1];
        if (nloc == 0u) { xcd_barrier_complete(bar, b.x, nloc, nx); b.st[0] = nloc; b.st[1] = nx; }
        nx &= 0xffffu;
        const unsigned old = xb_add(&bar[XB_XSUB(b.x)], 1u);
        const unsigned gen = old / nloc;
        if (old + 1u == (gen + 1u) * nloc) {
            __builtin_amdgcn_fence(__ATOMIC_RELEASE, "agent");
            asm volatile("s_waitcnt vmcnt(0)" ::: "memory");
            const unsigned og = xb_add(&bar[XB_TOP], 1u);
            const unsigned tg = og / nx;
            if (og + 1u == (tg + 1u) * nx) xb_add(&bar[XB_TOPGEN], 1u);
            else XB_SPIN(xb_ld(&bar[XB_TOPGEN]) == tg, bar);
            __builtin_amdgcn_fence(__ATOMIC_ACQUIRE, "agent");
            xb_add(&bar[XB_XGEN(b.x)], 1u);
            asm volatile("s_waitcnt vmcnt(0)" ::: "memory");
        } else {
            XB_SPIN(xb_ld(&bar[XB_XGEN(b.x)]) == gen, bar);
            __builtin_amdgcn_fence(__ATOMIC_ACQUIRE, "agent");
            asm volatile("s_waitcnt vmcnt(0)" ::: "memory");
        }
    }
    __syncthreads();
}

struct Args {
    const float *x, *g_mix, *w_in, *conv_w, *b_f, *w_conv_o, *w_attn_o, *w_out, *g_ffn, *w_router, *b_router, *w_gate_up, *b_gate_up, *w_down, *b_down, *g_final;
    float* out; unsigned char* ws; int ph_lo, ph_hi, li, pad;
};
struct Frame {
    LAS unsigned char* lds;
    int tid, lane, wave, vcu, G, bx;
};
__device__ __forceinline__ float wave_sum(float v) {
#pragma unroll
    for (int o = 1; o < 64; o <<= 1) v += __shfl_xor(v, o);
    return v;
}

struct SchedGrid {
    pg8::GridOrder o; unsigned A, B, atile, btile; int i0 = 0, i1 = 1 << 30;
    __device__ __forceinline__ bool next(int i, pg8::Unit& u) const { int pm, pn; if (i + i0 >= i1 || !o.map(i + i0, pm, pn)) return false;
        u.A = A + (unsigned)pm * atile; u.B = B + (unsigned)pn * btile; u.rows = 0u; u.pm = pm; u.pn = pn; u.e = 0; u.nvalid = 256; u.lrows = 0; return true; }
};
struct SchedMix {
    pg8::GridOrder o; unsigned A, B, atile, btile;
    __device__ __forceinline__ bool next(int i, pg8::Unit& u) const { int pm, pn; if (!o.map(i >> 1, pm, pn)) return false; const int hf = i & 1;
        u.A = A + (unsigned)pm * atile + hf * 1024u; u.B = B + (unsigned)pn * btile + hf * 1024u; u.rows = 0u; u.pm = pm; u.pn = pn; u.e = hf; u.nvalid = 256; u.lrows = 0; return true; }
};
struct SchedMoe {
    const LAS int* tab; int G, c, nct, gather; unsigned A, B, list, bexp, atile, btile;
    __device__ __forceinline__ bool next(int i, pg8::Unit& u) const {
        const int total = __builtin_amdgcn_readfirstlane(tab[32]); const long L = (long)i * G + c; if (L >= total) return false;
        int wgid = (int)L; { const int q = total / 8, r = total % 8, xcd = wgid % 8, off = wgid / 8; wgid = (xcd < r ? xcd * (q + 1) : r * (q + 1) + (xcd - r) * q) + off; }
        int tl_ = threadIdx.x; asm volatile("" : "+v"(tl_));
        const int ub1 = tab[(tl_ & 31) + 1];
        const unsigned long long mk = __ballot(wgid < ub1);
        const int e = __builtin_amdgcn_readfirstlane((int)__builtin_ctzll(mk)) & 31;
        const int l = wgid - __builtin_amdgcn_readfirstlane(tab[e]), nM = __builtin_amdgcn_readfirstlane(tab[64 + e]), pt = __builtin_amdgcn_readfirstlane(tab[96 + e]), cnt = __builtin_amdgcn_readfirstlane(tab[128 + e]);
        const int nig = 8 * nct, gid = l / nig, fm = gid * 8, gsz = (nM - fm) < 8 ? (nM - fm) : 8;
        const int rt = fm + ((l % nig) % gsz), ct = (l % nig) / gsz;
        u.e = e; u.pm = pt + rt; u.pn = ct; u.lrows = 0;
        u.B = B + (unsigned)e * bexp + (unsigned)ct * btile;
        if (gather) { u.A = A; u.rows = list + (unsigned)(e * LISTCAP + rt * 256) * 8u; const int nv = cnt - rt * 256; u.nvalid = nv < 256 ? nv : 256; }
        else { u.A = A + (unsigned)(pt + rt) * atile; u.rows = 0u; u.nvalid = 256; }
        return true;
    }
};

using pg8::f32x2; using pg8::u32x4; using pg8::cvt_pk_bf16; using pg8::bf_lo; using pg8::bf_hi;
__device__ __forceinline__ u32x4 pack8(const f32x4 a, const f32x4 b) { u32x4 w; w.x = cvt_pk_bf16(a[0], a[1]); w.y = cvt_pk_bf16(a[2], a[3]); w.z = cvt_pk_bf16(b[0], b[1]); w.w = cvt_pk_bf16(b[2], b[3]); return w; }
__device__ __forceinline__ float fast_exp(float x) { return __builtin_amdgcn_exp2f(x * 1.4426950408889634f); }
__device__ __forceinline__ unsigned pk4_fp8(float a, float b, float c, float d) { int w = __builtin_amdgcn_cvt_pk_fp8_f32(a, b, 0, false); w = __builtin_amdgcn_cvt_pk_fp8_f32(c, d, w, true); return (unsigned)w; }

#define EPI_COORDS() int tid_ = threadIdx.x; asm volatile("" : "+v"(tid_)); const int lane_ = tid_ & 63, wid_ = __builtin_amdgcn_readfirstlane(tid_ >> 6); \
    const int wr = wid_ >> 2, wc = wid_ & 3, fr = lane_ & 15, fq = lane_ >> 4
struct EpiG1 {
    static constexpr bool PERM = true; static constexpr bool BIAS_LDS = false;
    unsigned char* ws; float qscale;
    __device__ __forceinline__ bool operator()(f32x4 (&acc)[2][2][4][2], const pg8::Unit& u) const {
        EPI_COORDS();
        const int row0 = u.pm * 256 + wr * 64 + fr, cl = wc * 32 + 8 * fq, pn = u.pn;
        if (false) {
            size_t boff; int colt; float sc = 1.f;
            if (pn < 2) { boff = WS_CB; colt = pn * 256; }
            else { const int t = (pn - 6) >> 1; boff = WS_Q + (size_t)t * (WS_K - WS_Q); colt = ((pn - 6) & 1) * 256; if (t == 0) sc = qscale; }
            bf16* base = (bf16*)(ws + boff);
#pragma unroll
            for (int ai = 0; ai < 2; ++ai)
#pragma unroll
                for (int m = 0; m < 4; ++m) { bf16* rowp = base + (size_t)(row0 + ai * 128 + m * 16) * 512 + colt + cl;
#pragma unroll
                    for (int bj = 0; bj < 2; ++bj) *(u32x4*)(rowp + bj * 128) = pack8(acc[ai][bj][m][0] * sc, acc[ai][bj][m][1] * sc); }
        } else {
            const int T = pn; bf16* UC = (bf16*)(ws + WS_UC);
#pragma unroll
            for (int ai = 0; ai < 2; ++ai)
#pragma unroll
                for (int m = 0; m < 4; ++m) { bf16* rowp = UC + (size_t)(row0 + ai * 128 + m * 16) * 512 + T * 128 + cl;
                    *(u32x4*)rowp = pack8(acc[ai][0][m][0] * acc[ai][1][m][0], acc[ai][0][m][1] * acc[ai][1][m][1]); }
        }
        return false;
    }
};
struct EpiGate {
    static constexpr bool PERM = true; static constexpr bool BIAS_LDS = false;
    unsigned char* ws; float qscale;
    __device__ __forceinline__ bool operator()(f32x4 (&acc)[2][2][4][2], const pg8::Unit& u) const {
        EPI_COORDS();
        const int row0 = u.pm * 256 + wr * 64 + fr;
        if (u.pn < 8) {
            const int t = (u.pn - 2) >> 1; const float sc = (u.pn >= 2 && t == 0 ? qscale : 1.f) * 0.25f;
            bf16* base = (u.pn < 2 ? (bf16*)(ws + WS_CB) + u.pn * 256 : (bf16*)(ws + WS_Q + (size_t)t * (WS_K - WS_Q)) + ((u.pn - 2) & 1) * 256) + wc * 32 + 8 * fq;
#pragma unroll
            for (int bj = 0; bj < 2; ++bj) {
#pragma unroll
                for (int ai = 0; ai < 2; ++ai)
#pragma unroll
                    for (int m = 0; m < 4; ++m) *(u32x4*)(base + (size_t)(row0 + ai * 128 + m * 16) * 512 + bj * 128) = pack8(acc[ai][bj][m][0] * sc, acc[ai][bj][m][1] * sc);
                __builtin_amdgcn_sched_barrier(0);
            }
            return false;
        }
        const int col0 = (u.pn - 8) * 128 + wc * 32 + 8 * fq;
        unsigned char* G8 = ws + WS_G8;
#pragma unroll
        for (int bj = 0; bj < 2; ++bj) {
#pragma unroll
            for (int ai = 0; ai < 2; ++ai)
#pragma unroll
                for (int m = 0; m < 4; ++m) { f32x4 a0 = acc[ai][bj][m][0], a1 = acc[ai][bj][m][1];
#pragma unroll
                    for (int j = 0; j < 4; ++j) { a0[j] = __builtin_amdgcn_fmed3f(a0[j], -160.f, 160.f); a1[j] = __builtin_amdgcn_fmed3f(a1[j], -160.f, 160.f); }
                    v2u w8; w8.x = pk4_fp8(a0[0], a0[1], a0[2], a0[3]); w8.y = pk4_fp8(a1[0], a1[1], a1[2], a1[3]);
                    *(v2u*)(G8 + (size_t)(row0 + ai * 128 + m * 16) * 2048 + col0 + bj * 1024) = w8; }
            __builtin_amdgcn_sched_barrier(0);
        }
        return false;
    }
};
struct EpiMix {
    static constexpr bool PERM = true; static constexpr bool BIAS_LDS = false;
    const unsigned char* G8; bf16* MIX;
    __device__ __forceinline__ bool operator()(f32x4 (&acc)[2][2][4][2], const pg8::Unit& u) const {
        EPI_COORDS();
        const int row0 = u.pm * 256 + wr * 64 + fr, col0 = u.pn * 256 + wc * 32 + 8 * fq;
        const bool first = (u.e == 0);
        constexpr float KE = -0.25f * 1.4426950408889634f;
#define EM_DEC(w, lo4, hi4) do { const f32x2 a_ = __builtin_amdgcn_cvt_pk_f32_fp8((int)(w).x, false), b_ = __builtin_amdgcn_cvt_pk_f32_fp8((int)(w).x, true), \
            c_ = __builtin_amdgcn_cvt_pk_f32_fp8((int)(w).y, false), d_ = __builtin_amdgcn_cvt_pk_f32_fp8((int)(w).y, true); \
            lo4 = (f32x4){a_[0], a_[1], b_[0], b_[1]}; hi4 = (f32x4){c_[0], c_[1], d_[0], d_[1]}; } while (0)
#define EM_EXP(v) do { v = v * KE; _Pragma("unroll") for (int j = 0; j < 4; ++j) v[j] = __builtin_amdgcn_exp2f(v[j]); v = v + 1.0f; } while (0)
#define EM_RCP(v) do { _Pragma("unroll") for (int j = 0; j < 4; ++j) v[j] = __builtin_amdgcn_rcpf(v[j]); } while (0)
#pragma unroll
        for (int ai = 0; ai < 2; ++ai) {
            v2u ga[4][2], gc[4][2];
#pragma unroll
            for (int m = 0; m < 4; ++m)
#pragma unroll
                for (int bj = 0; bj < 2; ++bj) { const unsigned char* gp = G8 + (size_t)(row0 + ai * 128 + m * 16) * 2048 + col0 + bj * 128;
                    if (first) { gc[m][bj] = __builtin_nontemporal_load((const v2u*)gp); ga[m][bj] = *(const v2u*)(gp + 1024); }
                    else ga[m][bj] = __builtin_nontemporal_load((const v2u*)(gp + 1024)); }
            __builtin_amdgcn_sched_barrier(0);
            if (first) {
#pragma unroll
                for (int m = 0; m < 4; ++m)
#pragma unroll
                    for (int bj = 0; bj < 2; ++bj) { f32x4 a0, a1, c0, c1; EM_DEC(ga[m][bj], a0, a1); EM_DEC(gc[m][bj], c0, c1);
                        EM_EXP(a0); EM_EXP(a1); EM_EXP(c0); EM_EXP(c1); EM_RCP(c0); EM_RCP(c1);
                        acc[ai][bj][m][0] *= a0 * c0; acc[ai][bj][m][1] *= a1 * c1; __builtin_amdgcn_sched_barrier(0); }
            } else {
#pragma unroll
                for (int m = 0; m < 4; ++m) { const size_t off = (size_t)(row0 + ai * 128 + m * 16) * 1024 + col0;
#pragma unroll
                    for (int bj = 0; bj < 2; ++bj) { f32x4 a0, a1; EM_DEC(ga[m][bj], a0, a1); EM_EXP(a0); EM_EXP(a1); EM_RCP(a0); EM_RCP(a1);
                        *(u32x4*)(MIX + off + bj * 128) = pack8(acc[ai][bj][m][0] * a0, acc[ai][bj][m][1] * a1); __builtin_amdgcn_sched_barrier(0); } }
            }
            __builtin_amdgcn_sched_barrier(0);
        }
#undef EM_DEC
#undef EM_EXP
#undef EM_RCP
        return first;
    }
};
struct EpiOut {
    static constexpr bool PERM = true; static constexpr bool BIAS_LDS = false;
    const float* X; bf16* O;
    __device__ __forceinline__ bool operator()(f32x4 (&acc)[2][2][4][2], const pg8::Unit& u) const {
        EPI_COORDS();
        const int row0 = u.pm * 256 + wr * 64 + fr, col0 = u.pn * 256 + wc * 32 + 8 * fq;
        f32x4 xa[2][2][2], xb[2][2][2];
#define EO_LOAD(buf, q) do { _Pragma("unroll") for (int mm = 0; mm < 2; ++mm) _Pragma("unroll") for (int bj = 0; bj < 2; ++bj) { \
            const float* xp_ = X + (size_t)(row0 + ((q) >> 1) * 128 + (((q) & 1) * 2 + mm) * 16) * 1024 + col0 + bj * 128; \
            buf[mm][bj][0] = __builtin_nontemporal_load((const f32x4*)xp_); buf[mm][bj][1] = __builtin_nontemporal_load((const f32x4*)(xp_ + 4)); } } while (0)
#define EO_USE(buf, q) do { _Pragma("unroll") for (int mm = 0; mm < 2; ++mm) { const int ai_ = (q) >> 1, m_ = ((q) & 1) * 2 + mm; const size_t off_ = (size_t)(row0 + ai_ * 128 + m_ * 16) * 1024 + col0; \
            _Pragma("unroll") for (int bj = 0; bj < 2; ++bj) *(u32x4*)(O + off_ + bj * 128) = pack8(buf[mm][bj][0] + acc[ai_][bj][m_][0], buf[mm][bj][1] + acc[ai_][bj][m_][1]); } } while (0)
        EO_LOAD(xa, 0); EO_LOAD(xb, 1); __builtin_amdgcn_sched_barrier(0);
        EO_USE(xa, 0); __builtin_amdgcn_sched_barrier(0); EO_LOAD(xa, 2); __builtin_amdgcn_sched_barrier(0);
        EO_USE(xb, 1); __builtin_amdgcn_sched_barrier(0); EO_LOAD(xb, 3); __builtin_amdgcn_sched_barrier(0);
        EO_USE(xa, 2); __builtin_amdgcn_sched_barrier(0);
        EO_USE(xb, 3); __builtin_amdgcn_sched_barrier(0);
#undef EO_LOAD
#undef EO_USE
        return false;
    }
};
struct EpiSwiglu {
    static constexpr bool PERM = true; static constexpr bool BIAS_LDS = true;
    const float* bgu; unsigned char* ACT; const LAS unsigned char* gaux; LAS unsigned char* baux;
    __device__ __forceinline__ void bias_dma(const pg8::Unit& u, int par, int tid, int wid) const {
        const int i = tid & 255;
        const float* src = bgu + (size_t)u.e * 2048 + u.pn * 128 + (i < 128 ? i : 1024 + (i - 128));
        __builtin_amdgcn_global_load_lds((const unsigned*)src, (LAS unsigned*)(baux + par * 1024 + (wid & 3) * 256), 4, 0, 0);
    }
    __device__ __forceinline__ bool operator()(f32x4 (&acc)[2][2][4][2], const pg8::Unit& u) const {
        EPI_COORDS();
        const int row0 = u.pm * 256 + wr * 64 + fr, ch0 = u.pn * 128 + wc * 32 + 8 * fq;
        float rs[2][4];
#pragma unroll
        for (int ai = 0; ai < 2; ++ai)
#pragma unroll
            for (int m = 0; m < 4; ++m) { const int r = ai * 128 + wr * 64 + m * 16 + fr; rs[ai][m] = ((const LAS float*)(gaux + u.lrows))[2 * (r < u.nvalid ? r : 0) + 1]; }
        const LAS float* bp = (const LAS float*)(baux + (u.lrows >> 1)) + wc * 32 + 8 * fq;
        f32x4 bg[2], bl1[2];
#pragma unroll
        for (int n = 0; n < 2; ++n) { bg[n] = *(const LAS f32x4*)(bp + 4 * n); bl1[n] = *(const LAS f32x4*)(bp + 128 + 4 * n) + 1.0f; }
        constexpr float CE = -1.702f * 1.4426950408889634f;
#pragma unroll
        for (int ai = 0; ai < 2; ++ai)
#pragma unroll
            for (int m = 0; m < 4; ++m) { f32x4 av[2]; const float r1 = rs[ai][m];
#pragma unroll
                for (int n = 0; n < 2; ++n) { f32x4 g = acc[ai][0][m][n] * r1 + bg[n], l = acc[ai][1][m][n] * r1 + bl1[n];
#pragma unroll
                    for (int j = 0; j < 4; ++j) { g[j] = fminf(g[j], 7.0f); l[j] = __builtin_amdgcn_fmed3f(l[j], -6.0f, 8.0f); }
                    f32x4 t = g * CE;
#pragma unroll
                    for (int j = 0; j < 4; ++j) t[j] = __builtin_amdgcn_exp2f(t[j]);
                    t = t * 0.25f + 0.25f;
#pragma unroll
                    for (int j = 0; j < 4; ++j) t[j] = __builtin_amdgcn_rcpf(t[j]);
                    av[n] = (g * t) * l; }
                v2u w8; w8.x = pk4_fp8(av[0][0], av[0][1], av[0][2], av[0][3]); w8.y = pk4_fp8(av[1][0], av[1][1], av[1][2], av[1][3]);
                *(v2u*)(ACT + (size_t)(row0 + ai * 128 + m * 16) * 1024 + ch0) = w8; }
        return false;
    }
};
struct EpiDown {
    static constexpr bool PERM = true; static constexpr bool BIAS_LDS = true;
    const float* bd; unsigned char* Y; LAS unsigned char* baux;
    __device__ __forceinline__ void bias_dma(const pg8::Unit& u, int par, int tid, int wid) const {
        __builtin_amdgcn_global_load_lds((const unsigned*)(bd + (size_t)u.e * 1024 + u.pn * 256 + (tid & 255)), (LAS unsigned*)(baux + par * 1024 + (wid & 3) * 256), 4, 0, 0);
    }
    __device__ __forceinline__ bool operator()(f32x4 (&acc)[2][2][4][2], const pg8::Unit& u) const {
        EPI_COORDS();
        const int row0 = u.pm * 256 + wr * 64 + fr, col0 = u.pn * 256 + wc * 32 + 8 * fq;
        const LAS float* bp = (const LAS float*)(baux + (u.lrows >> 1)) + wc * 32 + 8 * fq;
#pragma unroll
        for (int bj = 0; bj < 2; ++bj) {
            const f32x4 b0 = *(const LAS f32x4*)(bp + bj * 128) * 16.f, b1 = *(const LAS f32x4*)(bp + bj * 128 + 4) * 16.f;
#pragma unroll
            for (int ai = 0; ai < 2; ++ai)
#pragma unroll
                for (int m = 0; m < 4; ++m) { const f32x4 a0 = acc[ai][bj][m][0] + b0, a1 = acc[ai][bj][m][1] + b1;
                    v2u w8; w8.x = pk4_fp8(a0[0], a0[1], a0[2], a0[3]); w8.y = pk4_fp8(a1[0], a1[1], a1[2], a1[3]);
                    *(v2u*)(Y + (size_t)(row0 + ai * 128 + m * 16) * 1024 + col0 + bj * 128) = w8; }
            __builtin_amdgcn_sched_barrier(0);
        }
        return false;
    }
};

__device__ __forceinline__ void p0_transpose_item(const float* W, int ldw, int k0, int n0s, bf16* WT, size_t drow0, int ldk, int kd0, LAS float* scr, int lane) {
#pragma unroll 8
    for (int i = 0; i < 32; ++i) { const int kk = 2 * i + (lane >> 5); scr[kk * 33 + (lane & 31)] = W[(size_t)(k0 + kk) * ldw + n0s + (lane & 31)]; }
    LDS_WAIT(); asm volatile("" ::: "memory");
    const int c = lane & 7;
#pragma unroll
    for (int j = 0; j < 4; ++j) { const int n = (lane >> 3) + 8 * j; const LAS float* s = scr + (8 * c) * 33 + n;
        v4u o; o.x = pk2(s[0 * 33], s[1 * 33]); o.y = pk2(s[2 * 33], s[3 * 33]); o.z = pk2(s[4 * 33], s[5 * 33]); o.w = pk2(s[6 * 33], s[7 * 33]);
        *(GAS v4u*)(WT + (drow0 + n) * (size_t)ldk + kd0 + 8 * c) = o; }
    LDS_WAIT(); asm volatile("" ::: "memory");
}
__device__ __forceinline__ void p0_item8_load(f32x4 (&v)[4][4], const float* W, int ldw, int k0, int n0s, int lane) {
    const int ng = lane & 7, kg0 = lane >> 3;
#pragma unroll
    for (int b = 0; b < 4; ++b)
#pragma unroll
        for (int r = 0; r < 4; ++r) v[b][r] = __builtin_nontemporal_load((const GAS f32x4*)(W + (size_t)(k0 + 4 * (kg0 + 8 * b) + r) * ldw + n0s + 4 * ng));
}
__device__ __forceinline__ void p0_item8_finish(const f32x4 (&v)[4][4], int k0, unsigned char* WT, size_t drow0, int ldk, int kd0, float scale, const float* kscale, LAS float* scrf, int lane) {
    LAS unsigned char* scr = (LAS unsigned char*)scrf;
    const int ng = lane & 7, kg0 = lane >> 3;
#pragma unroll
    for (int b = 0; b < 4; ++b) { const int kk = 4 * (kg0 + 8 * b);
        float ks[4];
#pragma unroll
        for (int r = 0; r < 4; ++r) ks[r] = kscale ? scale * kscale[k0 + kk + r] : scale;
#pragma unroll
        for (int c = 0; c < 4; ++c) *(LAS unsigned*)(scr + (4 * ng + c) * 144 + kk) = pk4_fp8(v[b][0][c] * ks[0], v[b][1][c] * ks[1], v[b][2][c] * ks[2], v[b][3][c] * ks[3]); }
    LDS_WAIT(); asm volatile("" ::: "memory");
    const int ch = lane & 7;
#pragma unroll
    for (int j = 0; j < 4; ++j) { const int n = (lane >> 3) + 8 * j; const v4u o = *(const LAS v4u*)(scr + n * 144 + 16 * ch);
        *(GAS v4u*)(WT + (drow0 + n) * (size_t)ldk + kd0 + 16 * ch) = o; }
    LDS_WAIT(); asm volatile("" ::: "memory");
}
__device__ __forceinline__ void p0_transpose_item8(const float* W, int ldw, int k0, int n0s, unsigned char* WT, size_t drow0, int ldk, int kd0, float scale, const float* kscale, LAS float* scrf, int lane) {
    f32x4 v[4][4]; p0_item8_load(v, W, ldw, k0, n0s, lane); p0_item8_finish(v, k0, WT, drow0, ldk, kd0, scale, kscale, scrf, lane);
}
__device__ __forceinline__ int win_src_col(int vb) {
    const int v = vb * 32;
    if (v < 512) return v;
    if (v < 1536) { const int T = (v - 512) >> 8, j = (v - 512) & 255; return j < 128 ? 512 + 128 * T + j : 1024 + 128 * T + (j - 128); }
    if (v < 3072) return v;
    { const int T = (v - 3072) >> 8, j = (v - 3072) & 255; return j < 128 ? 3080 + 128 * T + j : 4104 + 128 * T + (j - 128); }
}
__device__ __forceinline__ int wgu_src_col(int vb) { const int T = vb >> 3, j = (vb & 7) * 32; return j < 128 ? 128 * T + j : 1024 + 128 * T + (j - 128); }

struct ConvItem { const float* W; unsigned char* WT; const float* ks; int ldw, k0, n0s; size_t drow0; };
__device__ __forceinline__ ConvItem conv_item(const Args& a, int r) {
    unsigned char* ws = a.ws; ConvItem c; constexpr int I_GU = 32 * 8 * 64;
    if (r < I_GU) { const int e = r / 512, q = r % 512, kb = q / 64, vb = q % 64; c.W = a.w_gate_up + (size_t)e * 1024 * 2048; c.ldw = 2048; c.k0 = 128 * kb; c.n0s = wgu_src_col(vb); c.WT = ws + WS_WGU; c.drow0 = (size_t)e * 2048 + vb * 32; c.ks = a.g_ffn; }
    else { r -= I_GU; const int e = r / 256, q = r % 256, kb = q / 32, nb = q % 32; c.W = a.w_down + (size_t)e * 1024 * 1024; c.ldw = 1024; c.k0 = 128 * kb; c.n0s = 32 * nb; c.WT = ws + WS_WD; c.drow0 = (size_t)e * 1024 + nb * 32; c.ks = nullptr; }
    return c;
}
__device__ __forceinline__ void cvt_chunk(const Frame& F, const Args& a, int chunk) {
    LAS float* scr = (LAS float*)(F.lds + RING_OFF + F.wave * 16384);
    const ConvItem c = conv_item(a, chunk * 8 + F.wave);
    p0_transpose_item8(c.W, c.ldw, c.k0, c.n0s, c.WT, c.drow0, 1024, c.k0, 64.f, c.ks, scr, F.lane);
}
__device__ __forceinline__ void cvt_drain(const Frame& F, const Args& a, int upto) {
    volatile LAS unsigned* st = (volatile LAS unsigned*)(F.lds + MISC_OFF) + 8;
    unsigned* cnt = (unsigned*)(a.ws + WS_CTL) + CW_CVT;
    __syncthreads();
    for (unsigned p = 0;; p ^= 1u) {
        if (F.tid == 0) st[6 + p] = xb_add(cnt, 1u);
        __syncthreads();
        const unsigned ch = st[6 + p];
        if (ch < (unsigned)CVT_NCH) cvt_chunk(F, a, (int)ch);
        if (ch >= (unsigned)upto) break;
    }
    __syncthreads();
}
__device__ __forceinline__ void xcd_barrier_fill(const XcdBarrier& b, const Frame& F, const Args& a, const bool want_local = false) {
    asm volatile("s_waitcnt vmcnt(0)" ::: "memory");
    __syncthreads();
    volatile LAS unsigned* st = b.st;
    unsigned* bar = b.bar;
    if (F.tid == 0) {
        __builtin_amdgcn_s_waitcnt(0);
        unsigned nloc = st[0], nx = st[1];
        if (nloc == 0u) { xcd_barrier_complete(bar, b.x, nloc, nx); st[0] = nloc; st[1] = nx; }
        const bool local = want_local && (nx & 0x10000u) != 0u;
        nx &= 0xffffu;
        const unsigned old = xb_add(&bar[XB_XSUB(b.x)], 1u);
        const unsigned gen = old / nloc;
        if (old + 1u == (gen + 1u) * nloc) {
            if (!local) {
            __builtin_amdgcn_fence(__ATOMIC_RELEASE, "agent");
            asm volatile("s_waitcnt vmcnt(0)" ::: "memory");
            const unsigned og = xb_add(&bar[XB_TOP], 1u);
            const unsigned tg = og / nx;
            if (og + 1u == (tg + 1u) * nx) xb_add(&bar[XB_TOPGEN], 1u);
            else XB_SPIN(xb_ld(&bar[XB_TOPGEN]) == tg, bar);
            }
            xb_add(&bar[XB_XGEN(b.x)], 1u);
            __builtin_amdgcn_fence(__ATOMIC_ACQUIRE, "agent");
            asm volatile("s_waitcnt vmcnt(0)" ::: "memory");
            st[2] = 0xffffffffu;
        } else st[2] = gen;
    }
    __syncthreads();
    const unsigned gen = st[2];
    if (gen != 0xffffffffu) {
        unsigned* cnt = (unsigned*)(a.ws + WS_CTL) + CW_CVT;
        unsigned sp = 0u, exh = 0u;
        const unsigned nloc = st[0];
        for (unsigned p = 0;; p ^= 2u) {
            if (F.tid == 0) {
                const unsigned arr = xb_ld(&bar[XB_XSUB(b.x)]) - gen * nloc;
                unsigned done = (xb_ld(&bar[XB_XGEN(b.x)]) != gen) ? 1u : 0u, ch = 0xffffffffu;
                if (!done) {
                    if (!exh && arr + CVT_STOP < nloc) { ch = xb_add(cnt, 1u); if (ch >= (unsigned)CVT_NCH) { ch = 0xffffffffu; exh = 1u; } }
                    if (ch == 0xffffffffu) { __builtin_amdgcn_s_sleep(1);
                        if ((++sp & 255u) == 0u) { if (xb_ld(&bar[XB_TMO])) done = 1u; else if (sp > XB_SPIN_CAP) { atomicAdd(&bar[XB_TMO], 1u); done = 1u; } } }
                }
                st[3 + p] = done; st[4 + p] = ch;
            }
            __syncthreads();
            const unsigned done = st[3 + p], ch = st[4 + p];
            if (done) break;
            if (ch != 0xffffffffu) cvt_chunk(F, a, (int)ch);
        }
        if (F.tid == 0) { __builtin_amdgcn_fence(__ATOMIC_ACQUIRE, "agent"); asm volatile("s_waitcnt vmcnt(0)" ::: "memory"); }
    }
    __syncthreads();
}
__device__ __forceinline__ unsigned bf16_rne_bits(float f) { unsigned u = __builtin_bit_cast(unsigned, f); return (u + 0x7fffu + ((u >> 16) & 1u)) & 0xffff0000u; }
__device__ __forceinline__ void p0_prologue(const Frame& F, const Args& a) {
    unsigned char* ws = a.ws;
    bf16* Win_t = (bf16*)(ws + WS_WIN); bf16* W3_t = (bf16*)(ws + WS_W3); bf16* Wout_t = (bf16*)(ws + WS_WOUT);
    LAS float* scr = (LAS float*)(F.lds + RING_OFF + F.wave * 16384);
    const int gw = F.vcu * 8 + F.wave, NGW = F.G * 8;
    constexpr int I_IN = 16 * 32  , I_G8 = 8 * 128  , I_CO = 8 * 32, I_AO = 8 * 32, I_OUT = 16 * 32;
    constexpr int NITEMS = I_G8 + I_IN + I_CO + I_AO + I_OUT;
    { const int idx = F.vcu + F.G * F.tid;
      if (idx < 4096) { const int sidx = idx >> 7, eb = (idx >> 6) & 1, ln = idx & 63, c = ln & 15, q = ln >> 4;
        unsigned hb[8], lb[8];
#pragma unroll
        for (int j = 0; j < 8; ++j) { const int k = 32 * sidx + 8 * q + j; const float w = a.w_router[k * 32 + 16 * eb + c] * a.g_ffn[k];
            hb[j] = bf16_rne_bits(w); lb[j] = bf16_rne_bits(w - __uint_as_float(hb[j])); }
        v4u* img = (v4u*)(ws + WS_RIMG);
        img[idx] = (v4u){(hb[0] >> 16) | hb[1], (hb[2] >> 16) | hb[3], (hb[4] >> 16) | hb[5], (hb[6] >> 16) | hb[7]};
        img[4096 + idx] = (v4u){(lb[0] >> 16) | lb[1], (lb[2] >> 16) | lb[3], (lb[4] >> 16) | lb[5], (lb[6] >> 16) | lb[7]}; } }
    for (int it = gw; it < NITEMS; it += NGW) {
        int r = it;
        if (r < I_G8) { const int kb = r / 128, j = r % 128, vb = j < 16 ? j : j + 32;
            p0_transpose_item8(a.w_in, INCOLS, 128 * kb, win_src_col(vb), ws + WS_WG8, (size_t)j * 32, 1024, 128 * kb, 64.f, nullptr, scr, F.lane); continue; } r -= I_G8;
        if (r < I_IN) { const int kb = r / 32, vb = 16 + r % 32; p0_transpose_item(a.w_in, INCOLS, 64 * kb, win_src_col(vb), Win_t, (size_t)(vb - 16) * 32, 1024, 64 * kb, scr, F.lane); continue; } r -= I_IN;
        if (r < I_CO) { const int kb = r / 32, nb = r % 32; p0_transpose_item(a.w_conv_o, 1024, 64 * kb, 32 * nb, W3_t, (size_t)nb * 32, 1024, 64 * kb, scr, F.lane); continue; } r -= I_CO;
        if (r < I_AO) { const int kb = r / 32, nb = r % 32; p0_transpose_item(a.w_attn_o, 1024, 64 * kb, 32 * nb, W3_t, (size_t)nb * 32, 1024, 512 + 64 * kb, scr, F.lane); continue; } r -= I_AO;
        { const int kb = r / 32, nb = r % 32; p0_transpose_item(a.w_out, 1024, 64 * kb, 32 * nb, Wout_t, (size_t)nb * 32, 1024, 64 * kb, scr, F.lane); }
    }
    __syncthreads();
    LAS float* wf = (LAS float*)(F.lds + RING_OFF);
    for (int i = F.tid; i < 8 * 1024; i += 512) { const int c = i & 7, k = i >> 3; wf[c * 1024 + k] = a.w_in[(size_t)k * INCOLS + 3072 + c]; }
    __syncthreads();
    bf16* Hb = (bf16*)(ws + WS_H); float* LOGF = (float*)(ws + WS_LOGF);
    f32x4 gv[4];
#pragma unroll
    for (int j = 0; j < 4; ++j) gv[j] = ((const GAS f32x4*)a.g_mix)[F.lane + 64 * j];
    const float bfl = a.b_f[F.lane & 7];
    f32x4 xn[2][4];
#pragma unroll
    for (int q = 0; q < 2; ++q) { const int mq = gw + q * NGW; const GAS f32x4* xr = (const GAS f32x4*)(a.x + (size_t)(mq < NTOK ? mq : gw) * 1024) + F.lane;
#pragma unroll
        for (int j = 0; j < 4; ++j) xn[q][j] = __builtin_nontemporal_load(xr + 64 * j); }
    int par = 0;
    for (int m = gw; m < NTOK; m += NGW, par ^= 1) {
        f32x4 v[4]; float s = 0.f;
        { const int mq = m + 2 * NGW; const GAS f32x4* xr = (const GAS f32x4*)(a.x + (size_t)(mq < NTOK ? mq : gw) * 1024) + F.lane;
          if (par == 0) {
#pragma unroll
            for (int j = 0; j < 4; ++j) { v[j] = xn[0][j]; xn[0][j] = __builtin_nontemporal_load(xr + 64 * j); } }
          else {
#pragma unroll
            for (int j = 0; j < 4; ++j) { v[j] = xn[1][j]; xn[1][j] = __builtin_nontemporal_load(xr + 64 * j); } } }
#pragma unroll
        for (int j = 0; j < 4; ++j) s += (v[j].x * v[j].x + v[j].y * v[j].y) + (v[j].z * v[j].z + v[j].w * v[j].w);
        const float rstd = 1.f / sqrtf(wave_sum(s) * (1.f / 1024.f) + RMS_EPS);
#pragma unroll
        for (int j = 0; j < 4; ++j) v[j] = (v[j] * rstd) * gv[j];
        GAS unsigned long long* o8 = (GAS unsigned long long*)(Hb + (size_t)m * 1024) + F.lane;
#pragma unroll
        for (int j = 0; j < 4; ++j) o8[64 * j] = (unsigned long long)pk2(v[j].x, v[j].y) | ((unsigned long long)pk2(v[j].z, v[j].w) << 32);
        GAS unsigned* o4 = (GAS unsigned*)(ws + WS_H8 + (size_t)m * 1024) + F.lane;
#pragma unroll
        for (int j = 0; j < 4; ++j) o4[64 * j] = pk4_fp8(v[j].x * 16.f, v[j].y * 16.f, v[j].z * 16.f, v[j].w * 16.f);
        float p[8];
#pragma unroll
        for (int c = 0; c < 8; ++c) { float d = 0.f;
#pragma unroll
            for (int j = 0; j < 4; ++j) { const f32x4 w = ((const LAS f32x4*)(wf + c * 1024))[F.lane + 64 * j]; d += (v[j].x * w.x + v[j].y * w.y) + (v[j].z * w.z + v[j].w * w.w); }
            p[c] = d; }
#pragma unroll
        for (int c = 0; c < 4; ++c) { const bool up = (F.lane & 4) != 0; const float send = up ? p[c] : p[c + 4], keep = up ? p[c + 4] : p[c]; p[c] = keep + __shfl_xor(send, 4); }
#pragma unroll
        for (int c = 0; c < 2; ++c) { const bool up = (F.lane & 2) != 0; const float send = up ? p[c] : p[c + 2], keep = up ? p[c + 2] : p[c]; p[c] = keep + __shfl_xor(send, 2); }
        { const bool up = (F.lane & 1) != 0; const float send = up ? p[0] : p[1], keep = up ? p[1] : p[0]; p[0] = keep + __shfl_xor(send, 1); }
        float tot = p[0]; tot += __shfl_xor(tot, 8); tot += __shfl_xor(tot, 16); tot += __shfl_xor(tot, 32);
        if (F.lane < 8) { const float z = tot + bfl; LOGF[(size_t)m * 8 + F.lane] = fminf(z, 0.f) - log1pf(expf(-fabsf(z))); }
    }
}

__device__ __forceinline__ void p2_conv(const Frame& F, const Args& a) {
    unsigned char* ws = a.ws;
    const bf16* CB = (const bf16*)(ws + WS_CB); const bf16* UC = (const bf16*)(ws + WS_UC); bf16* A3 = (bf16*)(ws + WS_H);
    const int ch = F.lane * 8;
    float w0[8], w1[8], w2[8];
#pragma unroll
    for (int j = 0; j < 8; ++j) { w0[j] = a.conv_w[ch + j]; w1[j] = a.conv_w[512 + ch + j]; w2[j] = a.conv_w[1024 + ch + j]; }
    for (int panel = F.vcu; panel < NTOK / 256; panel += F.G) {
        const int r0 = panel * 256 + F.wave * 32;
        const GAS v4u* up = (const GAS v4u*)(UC + (size_t)r0 * 512 + ch); const GAS v4u* cp = (const GAS v4u*)(CB + (size_t)r0 * 512 + ch);
        v4u um2 = (v4u){0u, 0u, 0u, 0u}, um1 = um2;
        if ((r0 & (SEQLEN - 1)) != 0) { um2 = up[-128]; um1 = up[-64]; }
        v4u ub[2][8], cb[2][8];
#pragma unroll
        for (int j = 0; j < 8; ++j) { ub[0][j] = __builtin_nontemporal_load(up + 64 * j); cb[0][j] = __builtin_nontemporal_load(cp + 64 * j); }
#pragma unroll
        for (int b = 0; b < 4; ++b) {
            if (b < 3) {
#pragma unroll
                for (int j = 0; j < 8; ++j) { ub[(b + 1) & 1][j] = __builtin_nontemporal_load(up + 64 * (8 * (b + 1) + j)); cb[(b + 1) & 1][j] = __builtin_nontemporal_load(cp + 64 * (8 * (b + 1) + j)); }
            }
            __builtin_amdgcn_sched_barrier(0);
#pragma unroll
            for (int j = 0; j < 8; ++j) {
                const v4u u2 = ub[b & 1][j], c4 = cb[b & 1][j];
                const unsigned U0[4] = {um2.x, um2.y, um2.z, um2.w}, U1[4] = {um1.x, um1.y, um1.z, um1.w}, U2[4] = {u2.x, u2.y, u2.z, u2.w}, B[4] = {c4.x, c4.y, c4.z, c4.w};
                unsigned o[4];
#pragma unroll
                for (int q = 0; q < 4; ++q) {
                    const float lo = bf_lo(B[q]) * (w0[2 * q] * bf_lo(U0[q]) + w1[2 * q] * bf_lo(U1[q]) + w2[2 * q] * bf_lo(U2[q]));
                    const float hi = bf_hi(B[q]) * (w0[2 * q + 1] * bf_hi(U0[q]) + w1[2 * q + 1] * bf_hi(U1[q]) + w2[2 * q + 1] * bf_hi(U2[q]));
                    o[q] = pk2(lo, hi); }
                *(GAS v4u*)(A3 + (size_t)(r0 + 8 * b + j) * 1024 + ch) = (v4u){o[0], o[1], o[2], o[3]};
                um2 = um1; um1 = u2;
            }
            __builtin_amdgcn_sched_barrier(0);
        }
    }
}
__device__ __forceinline__ void p2_keybias(const Frame& F, const float* LOGF, int bh, LAS float* kb, LAS float* red) {
    const int b = bh >> 3, h = bh & 7;
    int tid = threadIdx.x; asm volatile("" : "+v"(tid));
    const int lane = tid & 63;
    const float* src = LOGF + ((size_t)b * SEQLEN) * 8 + h + (size_t)tid * 32;
    float v[4]; float s = 0.f;
#pragma unroll
    for (int j = 0; j < 4; ++j) { v[j] = src[j * 8]; s += v[j]; v[j] = s; }
    float ws_ = s;
#pragma unroll
    for (int o = 1; o < 64; o <<= 1) { const float t = __shfl_up(ws_, o); if (lane >= o) ws_ += t; }
    if (lane == 63) red[tid >> 6] = ws_;
    __syncthreads();
    float woff = 0.f;
    for (int w = 0; w < (tid >> 6); ++w) woff += red[w];
    const float base = woff + ws_ - s;
#pragma unroll
    for (int j = 0; j < 4; ++j) kb[tid * 4 + j] = -(base + v[j]) * 1.4426950408889634f;
    __syncthreads();
}

__device__ __forceinline__ void p5_router(const Frame& F, const Args& a) {
    typedef short bf16x8 __attribute__((ext_vector_type(8)));
    unsigned char* ws = a.ws;
    const bf16* X1 = (const bf16*)(ws + WS_X1B); unsigned char* H2 = ws + WS_H2;
    unsigned* CNT = (unsigned*)(ws + WS_CTL) + CW_CNT; v2u* LIST = (v2u*)(ws + WS_LIST); unsigned* TOKSLOT = (unsigned*)(ws + WS_TOKSLOT); float* TOKW = (float*)(ws + WS_TOKW);
    LAS v4u* whi = (LAS v4u*)(F.lds + RING_OFF); LAS v4u* wlo = whi + 4096;
    { const v4u* img = (const v4u*)(ws + WS_RIMG);
#pragma unroll
      for (int i = 0; i < 16; ++i) __builtin_amdgcn_global_load_lds((const unsigned*)(img + (F.wave * 16 + i) * 64 + F.lane), (LAS unsigned*)(whi + (F.wave * 16 + i) * 64), 16, 0, 0);
      asm volatile("s_waitcnt vmcnt(0)" ::: "memory"); }
    LAS int* hist = (LAS int*)(F.lds + P5_OFF); LAS int* basev = hist + 32; LAS unsigned* ent = (LAS unsigned*)(hist + 64);
    LAS float* rstd_l = (LAS float*)(F.lds + GAUX_OFF);
    const int fr = F.lane & 15, fq = F.lane >> 4;
    const float br0 = a.b_router[fr], br1 = a.b_router[16 + fr];
    __syncthreads();
    for (int chunk = F.vcu; chunk < NTOK / 256; chunk += F.G) {
        if (F.tid < 32) hist[F.tid] = 0;
        __syncthreads();
#pragma unroll 1
        for (int pass = 0; pass < 2; ++pass) {
            const int rl0 = pass * 128 + F.wave * 16;
            const bf16* xp = X1 + (size_t)(chunk * 256 + rl0 + fr) * 1024 + 8 * fq;
            unsigned char* hp = H2 + (size_t)(chunk * 256 + rl0 + fr) * 1024 + 8 * fq;
            f32x4 acc0 = (f32x4){0.f, 0.f, 0.f, 0.f}, acc1 = acc0; float ss = 0.f;
            v4u buf[8];
#pragma unroll
            for (int p = 0; p < 8; ++p) buf[p] = *(const GAS v4u*)(xp + 32 * p);
#pragma unroll 1
            for (int s0 = 0; s0 < 32; s0 += 8) {
#pragma unroll
                for (int p = 0; p < 8; ++p) { const int sidx = s0 + p;
                    const v4u xv = buf[p];
                    if (s0 + 8 < 32) buf[p] = *(const GAS v4u*)(xp + 32 * (sidx + 8));
                    const float xs[8] = {bf_lo(xv.x), bf_hi(xv.x), bf_lo(xv.y), bf_hi(xv.y), bf_lo(xv.z), bf_hi(xv.z), bf_lo(xv.w), bf_hi(xv.w)};
#pragma unroll
                    for (int j = 0; j < 8; ++j) ss += xs[j] * xs[j];
                    v2u h8; h8.x = pk4_fp8(xs[0] * 16.f, xs[1] * 16.f, xs[2] * 16.f, xs[3] * 16.f); h8.y = pk4_fp8(xs[4] * 16.f, xs[5] * 16.f, xs[6] * 16.f, xs[7] * 16.f);
                    *(GAS v2u*)(hp + 32 * sidx) = h8;
                    const bf16x8 ah = __builtin_bit_cast(bf16x8, xv);
                    const bf16x8 wh0 = __builtin_bit_cast(bf16x8, whi[(sidx * 2 + 0) * 64 + F.lane]), wh1 = __builtin_bit_cast(bf16x8, whi[(sidx * 2 + 1) * 64 + F.lane]);
                    const bf16x8 wl0 = __builtin_bit_cast(bf16x8, wlo[(sidx * 2 + 0) * 64 + F.lane]), wl1 = __builtin_bit_cast(bf16x8, wlo[(sidx * 2 + 1) * 64 + F.lane]);
                    acc0 = __builtin_amdgcn_mfma_f32_16x16x32_bf16(ah, wh0, acc0, 0, 0, 0); acc1 = __builtin_amdgcn_mfma_f32_16x16x32_bf16(ah, wh1, acc1, 0, 0, 0);
                    acc0 = __builtin_amdgcn_mfma_f32_16x16x32_bf16(ah, wl0, acc0, 0, 0, 0); acc1 = __builtin_amdgcn_mfma_f32_16x16x32_bf16(ah, wl1, acc1, 0, 0, 0); }
            }
            ss += __shfl_xor(ss, 16); ss += __shfl_xor(ss, 32);
            const float rstd = 1.f / sqrtf(ss * (1.f / 1024.f) + RMS_EPS);
            if (fq == 0) rstd_l[rl0 + fr] = rstd;
#pragma unroll
            for (int reg = 0; reg < 4; ++reg) {
                const float rsr = __shfl(rstd, 4 * fq + reg);
                float l0 = acc0[reg] * rsr + br0, l1 = acc1[reg] * rsr + br1;
                float tv[4]; int ti[4];
#pragma unroll
                for (int k = 0; k < 4; ++k) { float bv; int bi; if (l1 > l0) { bv = l1; bi = 16 + fr; } else { bv = l0; bi = fr; }
#pragma unroll
                    for (int o = 1; o < 16; o <<= 1) { const float ov = __shfl_xor(bv, o); const int oi = __shfl_xor(bi, o); if (ov > bv || (ov == bv && oi < bi)) { bv = ov; bi = oi; } }
                    tv[k] = bv; ti[k] = bi; if (bi == fr) l0 = -INFINITY; if (bi == 16 + fr) l1 = -INFINITY; }
                const float e1 = expf(tv[1] - tv[0]), e2 = expf(tv[2] - tv[0]), e3 = expf(tv[3] - tv[0]);
                const float inv = 1.f / (1.f + e1 + e2 + e3);
                if (fr < 4) { const int ek = fr == 0 ? ti[0] : (fr == 1 ? ti[1] : (fr == 2 ? ti[2] : ti[3]));
                    const float gk = (fr == 0 ? 1.f : (fr == 1 ? e1 : (fr == 2 ? e2 : e3))) * inv;
                    const int rl = rl0 + 4 * fq + reg;
                    const int pos = __hip_atomic_fetch_add(&hist[ek], 1, __ATOMIC_RELAXED, __HIP_MEMORY_SCOPE_WORKGROUP);
                    ent[rl * 4 + fr] = ((unsigned)ek << 16) | (unsigned)pos; TOKW[(size_t)(chunk * 256 + rl) * 4 + fr] = gk; }
            }
        }
        __syncthreads();
        if (F.tid < 32) { const int n = hist[F.tid]; basev[F.tid] = n ? (int)__hip_atomic_fetch_add(CNT + F.tid, (unsigned)n, RLX_AGENT) : 0; }
        __syncthreads();
        for (int i = F.tid; i < 1024; i += 512) { const unsigned en = ent[i]; const int e = (int)(en >> 16), pos = basev[e] + (int)(en & 0xffffu); const int rl = i >> 2, row = chunk * 256 + rl;
            LIST[(size_t)e * LISTCAP + pos] = (v2u){(unsigned)row, __float_as_uint(rstd_l[rl])}; TOKSLOT[(size_t)row * 4 + (i & 3)] = ((unsigned)e << 16) | (unsigned)pos; }
        __syncthreads();
    }
}
__device__ __forceinline__ void moe_table(const Frame& F, const Args& a, int nct) {
    LAS int* tab = (LAS int*)(F.lds + MOETAB_OFF);
    unsigned* CNT = (unsigned*)(a.ws + WS_CTL) + CW_CNT;
    __syncthreads();
    if (F.tid < 64) {
        const int e = F.lane;
        const int c = (e < 32) ? (int)__hip_atomic_load(CNT + (e & 31), RLX_AGENT) : 0;
        const int ntl = (c + 255) >> 8;
        int ps = ntl;
#pragma unroll
        for (int o = 1; o < 32; o <<= 1) { const int t = __shfl_up(ps, o); if (e >= o) ps += t; }
        const int pt = ps - ntl;
        if (e < 32) { tab[e] = pt * nct; tab[64 + e] = ntl; tab[96 + e] = pt; tab[128 + e] = c; }
        if (e == 31) tab[32] = ps * nct;
    }
    __syncthreads();
}
#define P8_SLOTS(S, W, mm) do { const int mc_ = (mm) < NTOK ? (mm) : gw; S = TOKSLOT[mc_]; W = TOKW[mc_]; } while (0)
#define P8_ISSUE(V, Y, S, mm) do { const int mc_ = (mm) < NTOK ? (mm) : gw; const GAS v2u* xr_ = (const GAS v2u*)(X1B + (size_t)mc_ * 1024) + F.lane; \
    _Pragma("unroll") for (int j = 0; j < 4; ++j) { const v2u xb_ = __builtin_nontemporal_load(xr_ + 64 * j); V[j] = (f32x4){bf_lo(xb_.x), bf_hi(xb_.x), bf_lo(xb_.y), bf_hi(xb_.y)}; } \
    const unsigned tsv_[4] = {S.x, S.y, S.z, S.w}; \
    _Pragma("unroll") for (int k = 0; k < 4; ++k) { const int e_ = (int)(tsv_[k] >> 16) & 31, pos_ = (int)(tsv_[k] & 0xffffu); const size_t slot_ = (size_t)tab[96 + e_] * 256 + pos_; \
        const GAS unsigned* yr_ = (const GAS unsigned*)(Y_ + slot_ * 1024) + F.lane; \
        _Pragma("unroll") for (int j = 0; j < 4; ++j) Y[k][j] = __builtin_nontemporal_load(yr_ + 64 * j); } } while (0)
#define P8_FINISH(V, Y, W, mm) do { const float w_[4] = {W.x, W.y, W.z, W.w}; \
    _Pragma("unroll") for (int k = 0; k < 4; ++k) _Pragma("unroll") for (int j = 0; j < 4; ++j) { const f32x2 lo_ = __builtin_amdgcn_cvt_pk_f32_fp8((int)Y[k][j], false), hi_ = __builtin_amdgcn_cvt_pk_f32_fp8((int)Y[k][j], true); \
        V[j] += (f32x4){lo_.x, lo_.y, hi_.x, hi_.y} * (w_[k] * 0.0625f); } \
    float s_ = 0.f; _Pragma("unroll") for (int j = 0; j < 4; ++j) s_ += (V[j].x * V[j].x + V[j].y * V[j].y) + (V[j].z * V[j].z + V[j].w * V[j].w); \
    const float rstd_ = 1.f / sqrtf(wave_sum(s_) * (1.f / 1024.f) + RMS_EPS); \
    if ((mm) < NTOK) { GAS f32x4* xo_ = (GAS f32x4*)(OUT + (size_t)(mm) * 1024) + F.lane; _Pragma("unroll") for (int j = 0; j < 4; ++j) __builtin_nontemporal_store((V[j] * rstd_) * gv[j], xo_ + 64 * j); } } while (0)
__device__ __forceinline__ void p8_combine(const Frame& F, const Args& a) {
    unsigned char* ws = a.ws;
    const LAS int* tab = (const LAS int*)(F.lds + MOETAB_OFF);
    const unsigned char* Y_ = ws + WS_Y; const v4u* TOKSLOT = (const v4u*)(ws + WS_TOKSLOT); const f32x4* TOKW = (const f32x4*)(ws + WS_TOKW);
    float* OUT = a.out; const bf16* X1B = (const bf16*)(ws + WS_X1B);
    f32x4 gv[4];
#pragma unroll
    for (int j = 0; j < 4; ++j) gv[j] = ((const GAS f32x4*)a.g_final)[F.lane + 64 * j];
    const int gw = F.vcu * 8 + F.wave, NGW = F.G * 8;
    f32x4 vA[4], vB[4]; unsigned yA[4][4], yB[4][4]; v4u sA, sB; f32x4 wA, wB, wC;
    int m = gw;
    P8_SLOTS(sA, wA, m); P8_ISSUE(vA, yA, sA, m); P8_SLOTS(sB, wB, m + NGW);
    for (; m < NTOK; m += 2 * NGW) {
        P8_ISSUE(vB, yB, sB, m + NGW);
        P8_SLOTS(sA, wC, m + 2 * NGW);
        P8_FINISH(vA, yA, wA, m);
        P8_ISSUE(vA, yA, sA, m + 2 * NGW);
        wA = wC; P8_SLOTS(sB, wC, m + 3 * NGW);
        P8_FINISH(vB, yB, wB, m + NGW);
        wB = wC;
    }
}
#undef P8_SLOTS
#undef P8_ISSUE
#undef P8_FINISH

constexpr int N_PHASES = 9;
typedef const __attribute__((address_space(4))) Args* KArgs;
__device__ __forceinline__ Args load_args(KArgs p) { Args a;
    a.x = p->x; a.g_mix = p->g_mix; a.w_in = p->w_in; a.conv_w = p->conv_w; a.b_f = p->b_f; a.w_conv_o = p->w_conv_o; a.w_attn_o = p->w_attn_o; a.w_out = p->w_out; a.g_ffn = p->g_ffn;
    a.w_router = p->w_router; a.b_router = p->b_router; a.w_gate_up = p->w_gate_up; a.b_gate_up = p->b_gate_up; a.w_down = p->w_down; a.b_down = p->b_down; a.g_final = p->g_final;
    a.out = p->out; a.ws = p->ws; a.ph_lo = p->ph_lo; a.ph_hi = p->ph_hi; a.li = p->li; a.pad = 0; return a; }
#define PHASE_ENV() \
    KArgs kp_ = (KArgs)__builtin_amdgcn_kernarg_segment_ptr(); asm volatile("" : "+s"(kp_)); const Args args = load_args(kp_); \
    Frame F; { int t_ = threadIdx.x; asm volatile("" : "+v"(t_)); int bx_ = blockIdx.x; asm volatile("" : "+s"(bx_)); int g_ = gridDim.x; asm volatile("" : "+s"(g_)); \
      F.lds = (LAS unsigned char*)lds; F.tid = t_; F.lane = t_ & 63; F.wave = __builtin_amdgcn_readfirstlane(t_ >> 6); F.G = g_; F.vcu = (g_ % 8 == 0) ? (bx_ % 8) * (g_ / 8) + bx_ / 8 : bx_; F.bx = bx_; } \
    unsigned char* ws = args.ws; (void)ws
__global__ void __launch_bounds__(512, 2) fwd_kernel(Args args_by_value) {
    extern __shared__ __attribute__((aligned(16))) unsigned char lds[];
    int lo, hi; XcdBarrier bar;
    {
        PHASE_ENV();
        for (int u = F.tid; u < (LDS_BYTES - LDSCTL_OFF) / 4; u += 512) ((LAS unsigned*)(F.lds + LDSCTL_OFF))[u] = 0u;
        __syncthreads();
        volatile LAS unsigned* MISC = (volatile LAS unsigned*)(F.lds + MISC_OFF);
        bar = xcd_barrier_post((unsigned*)(ws + WS_CTL) + CW_BAR + args.li * XCD_BAR_WORDS, MISC + 8);
        lo = args.ph_lo; hi = args.ph_hi;
    }
#ifndef PHMASK
#define PHMASK 0x1ff
#endif
#define IN(k) (((PHMASK >> (k)) & 1) && lo <= (k) && (k) < hi)
#define SEAM(k) do { if (lo <= (k) && (k) + 1 < hi) { PHASE_ENV(); xcd_barrier_fill(bar, F, args, ((k) >= 1 && (k) <= 4) && PROBE_REPEAT_PHASE < 0); } } while (0)

    if (IN(0)) { PHASE_ENV(); p0_prologue(F, args); }
    SEAM(0);
    if (IN(1)) {
        PHASE_ENV();
        { EpiG1 E{ws, attn_body::C2};
          SchedGrid S; S.o.init(NTOK / 256, 4, F.G, F.bx); S.A = (unsigned)WS_H; S.B = (unsigned)WS_WIN; S.atile = 256 * 1024 * 2; S.btile = 256 * 1024 * 2;
          pg8::gemm_phase<EpiG1, SchedGrid, false, true>(F.lds + RING_OFF, (const char*)ws, 1024, 1024, 16, S, E); }
        { SchedGrid S; S.o.init(NTOK / 256, 16, F.G, F.bx); S.A = (unsigned)WS_H8; S.B = (unsigned)WS_WG8; S.atile = 256 * 1024; S.btile = 256 * 1024;
          EpiGate E{ws, attn_body::C2};
          pg8::gemm_phase<EpiGate, SchedGrid, false, true, true>(F.lds + RING_OFF, (const char*)ws, 512, 512, 8, S, E, 0x7b7b7b7b  ); }
    }
    SEAM(1);
    if (IN(2)) {
        { PHASE_ENV(); p2_conv(F, args); }
        PHASE_ENV();
        const attn_body::bf16* Qp = (const attn_body::bf16*)(ws + WS_Q); const attn_body::bf16* Kp = (const attn_body::bf16*)(ws + WS_K); const attn_body::bf16* Vp = (const attn_body::bf16*)(ws + WS_V);
        attn_body::bf16* Op = (attn_body::bf16*)(ws + WS_H) + 512;
        for (int bh = F.vcu; bh < NBATCH * NHEADS; bh += F.G) {
            p2_keybias(F, (const float*)(ws + WS_LOGF), bh, (LAS float*)(F.lds + RING_OFF + attn_body::LDS_KB), (LAS float*)(F.lds + MISC_OFF + 64));
            attn_body::bf16x8 qr[4];
            for (int qb = attn_body::NQB - 1; qb >= 0; --qb) attn_body::attn_unit<60>(bh >> 3, bh & 7, qb, Qp, Kp, Vp, Op, (char*)lds + RING_OFF, qr);
            __syncthreads();
        }
    }
    SEAM(2);
    if (IN(3)) {
        PHASE_ENV();
        SchedMix S; S.o.init(NTOK / 256, 4, F.G, F.bx); S.A = (unsigned)WS_H; S.B = (unsigned)WS_W3; S.atile = 256 * 1024 * 2; S.btile = 256 * 1024 * 2;
        EpiMix E{ws + WS_G8, (bf16*)(ws + WS_MIX)};
        pg8::gemm_phase<EpiMix, SchedMix, false, true>(F.lds + RING_OFF, (const char*)ws, 1024, 1024, 8, S, E);
    }
    SEAM(3);
    if (IN(4)) {
        PHASE_ENV();
        SchedGrid S; S.o.init(NTOK / 256, 4, F.G, F.bx); S.A = (unsigned)WS_MIX; S.B = (unsigned)WS_WOUT; S.atile = 256 * 1024 * 2; S.btile = 256 * 1024 * 2;
        EpiOut E{args.x, (bf16*)(ws + WS_X1B)};
        pg8::gemm_phase<EpiOut, SchedGrid, false, true>(F.lds + RING_OFF, (const char*)ws, 1024, 1024, 16, S, E);
    }
    SEAM(4);
    if (IN(5)) { PHASE_ENV(); p5_router(F, args); cvt_drain(F, args, CVT_NGU); }
    SEAM(5);
    if (IN(6)) {
        PHASE_ENV();
        moe_table(F, args, 8);
        SchedMoe S; S.tab = (const LAS int*)(F.lds + MOETAB_OFF); S.G = F.G; S.c = F.bx; S.nct = 8; S.gather = 1;
        S.A = (unsigned)WS_H2; S.B = (unsigned)WS_WGU; S.list = (unsigned)WS_LIST; S.bexp = 2048u * 1024u; S.atile = 256u * 1024u; S.btile = 256u * 1024u;
        EpiSwiglu E{args.b_gate_up, ws + WS_ACT, (const LAS unsigned char*)(F.lds + GAUX_OFF), F.lds + P5_OFF};
        pg8::gemm_phase<EpiSwiglu, SchedMoe, true, true, true>(F.lds + RING_OFF, (const char*)ws, 512, 512, 8, S, E, 0x7a7a7a7a  , F.lds + GAUX_OFF);
        cvt_drain(F, args, CVT_NCH);
    }
    SEAM(6);
    if (IN(7)) {
        PHASE_ENV();
        moe_table(F, args, 4);
        SchedMoe S; S.tab = (const LAS int*)(F.lds + MOETAB_OFF); S.G = F.G; S.c = F.bx; S.nct = 4; S.gather = 0;
        S.A = (unsigned)WS_ACT; S.B = (unsigned)WS_WD; S.list = 0u; S.bexp = 1024u * 1024u; S.atile = 256u * 1024u; S.btile = 256u * 1024u;
        EpiDown E{args.b_down, ws + WS_Y, F.lds + P5_OFF};
        pg8::gemm_phase<EpiDown, SchedMoe, false, true, true>(F.lds + RING_OFF, (const char*)ws, 512, 512, 8, S, E, 0x7d7d7d7d  );
    }
    SEAM(7);
    if (IN(8)) { PHASE_ENV(); moe_table(F, args, 4); p8_combine(F, args); }
#undef IN
#undef SEAM
}

extern "C" void kernel_launch(void* const* d_in, const int* in_sizes, int n_in, void* d_out, int out_size, void* d_ws, size_t ws_size, hipStream_t stream) {
    static int grid = 0;
    if (grid == 0) {
        if (n_in != 16 || in_sizes[0] != NTOK * DMODEL || out_size != NTOK * DMODEL || ws_size < WS_END) { fprintf(stderr, "kernel_launch: unexpected shapes / workspace (%zu)\n", ws_size); grid = -1; return; }
        int dev = 0, cus = 0, per_cu = 0;
        if (hipGetDevice(&dev) != hipSuccess || hipDeviceGetAttribute(&cus, hipDeviceAttributeMultiprocessorCount, dev) != hipSuccess) { grid = -1; return; }
        if (hipFuncSetAttribute((const void*)fwd_kernel, hipFuncAttributeMaxDynamicSharedMemorySize, LDS_BYTES) != hipSuccess) { grid = -1; return; }
        if (hipOccupancyMaxActiveBlocksPerMultiprocessor(&per_cu, (const void*)fwd_kernel, 512, LDS_BYTES) != hipSuccess || per_cu < 1) fprintf(stderr, "kernel_launch: occupancy query reports %d\n", per_cu);
        (void)hipGetLastError();
        grid = cus;
    }
    if (grid < 0) return;
    if (hipMemsetAsync((char*)d_ws + WS_CTL, 0, CTL_ZERO_BYTES, stream) != hipSuccess) return;
    Args a{};
    a.x = (const float*)d_in[0]; a.g_mix = (const float*)d_in[1]; a.w_in = (const float*)d_in[2]; a.conv_w = (const float*)d_in[3]; a.b_f = (const float*)d_in[4];
    a.w_conv_o = (const float*)d_in[5]; a.w_attn_o = (const float*)d_in[6]; a.w_out = (const float*)d_in[7]; a.g_ffn = (const float*)d_in[8]; a.w_router = (const float*)d_in[9];
    a.b_router = (const float*)d_in[10]; a.w_gate_up = (const float*)d_in[11]; a.b_gate_up = (const float*)d_in[12]; a.w_down = (const float*)d_in[13]; a.b_down = (const float*)d_in[14];
    a.g_final = (const float*)d_in[15];
    a.out = (float*)d_out; a.ws = (unsigned char*)d_ws;
    if (PROBE_REPEAT_PHASE < 0) { a.ph_lo = 0; a.ph_hi = N_PHASES; a.li = 0; hipLaunchKernelGGL(fwd_kernel, dim3(grid), dim3(512), LDS_BYTES, stream, a); }
    else if (PROBE_REPEAT_PHASE == 80) {
        a.ph_lo = 0; a.ph_hi = 8; a.li = 0; hipLaunchKernelGGL(fwd_kernel, dim3(grid), dim3(512), LDS_BYTES, stream, a);
        (void)hipMemcpyAsync((char*)d_ws + WS_ACT, d_out, (size_t)NTOK * DMODEL * 4, hipMemcpyDeviceToDevice, stream);
        a.ph_lo = 8; a.ph_hi = 9; a.li = 1; if (PROBE_REPEAT_PHASE == 8) hipLaunchKernelGGL(fwd_kernel, dim3(grid), dim3(512), LDS_BYTES, stream, a);
        (void)hipMemcpyAsync(d_out, (char*)d_ws + WS_ACT, (size_t)NTOK * DMODEL * 4, hipMemcpyDeviceToDevice, stream);
        a.li = 2; hipLaunchKernelGGL(fwd_kernel, dim3(grid), dim3(512), LDS_BYTES, stream, a);
    }
    else {
        const int k = PROBE_REPEAT_PHASE; const int cuts[4] = {0, k + 1, k + 1, N_PHASES}; const int los[3] = {0, k, k + 1};
        for (int li = 0; li < 3; ++li) { a.ph_lo = los[li]; a.ph_hi = cuts[li + 1]; a.li = li; if (li == 1 && k == 5) (void)hipMemsetAsync((char*)d_ws + WS_CTL + CW_CNT * 4, 0, 256, stream);
            if (a.ph_lo < a.ph_hi) hipLaunchKernelGGL(fwd_kernel, dim3(grid), dim3(512), LDS_BYTES, stream, a); } }
}
```
